# Optimizing an MI355X kernel written in HIP

```python
import math
import jax
import jax.numpy as jnp
from jax import lax
import numpy as np


D_MODEL = 1024
BATCH = 2
SEQ = 8192
DEPTH = 4

CHUNK = 64
N_MIXERS = 3
N_A = (DEPTH + 2) // 3
N_B = (DEPTH + 1) // 3
N_C = DEPTH // 3
D_FF = 2816
EPS = 1e-6
NEG_INF = -1e30
HEADS_A = 16
HEAD_DIM_A = D_MODEL // HEADS_A
LEFT_CHUNKS = 8
BAND = (LEFT_CHUNKS + 1) * CHUNK
REL_CLIP = 128
GMLP_CHUNK = 128
D_GATE = D_MODEL
GMLP_GROUPS = 8
GMLP_GROUP_DIM = D_GATE // GMLP_GROUPS
HEADS_C = 8
HEAD_DIM_C = D_MODEL // (2 * HEADS_C)
Q_BLOCK = 128

kernel_name = 'hybrid_streaming_interleaved_block'


def rms_norm(x, g):
    xf = x.astype(jnp.float32)
    y = xf * lax.rsqrt(jnp.mean(xf * xf, axis=-1, keepdims=True) + EPS)
    return (y * g.astype(jnp.float32)).astype(x.dtype)


def swiglu(h, w_in, w_out):
    gate, up = jnp.split(h @ w_in, 2, axis=-1)
    return (jax.nn.silu(gate) * up) @ w_out


def mixer_a(h, w_qkv, rel_bias, w_o):
    B, S, D = h.shape
    nc = S // CHUNK
    pad = LEFT_CHUNKS * CHUNK
    q, k, v = jnp.split(h @ w_qkv, 3, axis=-1)
    q = q.reshape(B, nc, CHUNK, HEADS_A, HEAD_DIM_A).transpose(1, 0, 2, 3, 4)
    k = jnp.pad(k.reshape(B, S, HEADS_A, HEAD_DIM_A), ((0, 0), (pad, 0), (0, 0), (0, 0)))
    v = jnp.pad(v.reshape(B, S, HEADS_A, HEAD_DIM_A), ((0, 0), (pad, 0), (0, 0), (0, 0)))
    rel = jnp.clip(pad + jnp.arange(CHUNK)[:, None] - jnp.arange(BAND)[None, :], -REL_CLIP, REL_CLIP) + REL_CLIP
    bias = rel_bias.astype(jnp.float32)[:, rel]
    scale = HEAD_DIM_A ** -0.5

    def one_chunk(args):
        c, qc = args
        start = c * CHUNK
        kb = lax.dynamic_slice_in_dim(k, start, BAND, axis=1)
        vb = lax.dynamic_slice_in_dim(v, start, BAND, axis=1)
        s = jnp.einsum('bqhd,bkhd->bhqk', qc, kb).astype(jnp.float32) * scale + bias
        valid = (start - pad + jnp.arange(BAND)) >= 0
        s = jnp.where(valid, s, NEG_INF)
        p = jax.nn.softmax(s, axis=-1).astype(vb.dtype)
        return jnp.einsum('bhqk,bkhd->bqhd', p, vb)

    o = lax.map(one_chunk, (jnp.arange(nc), q))
    o = o.transpose(1, 0, 2, 3, 4).reshape(B, S, D)
    return o @ w_o


def mixer_b(h, w_in, ln_g, ln_b, w_s, b_s, w_o):
    B, S, _ = h.shape
    n = S // GMLP_CHUNK
    u, v = jnp.split(jax.nn.gelu(h @ w_in, approximate=False), 2, axis=-1)
    vf = v.astype(jnp.float32)
    mu = jnp.mean(vf, axis=-1, keepdims=True)
    var = jnp.mean(jnp.square(vf - mu), axis=-1, keepdims=True)
    v = ((vf - mu) * lax.rsqrt(var + EPS) * ln_g.astype(jnp.float32) + ln_b.astype(jnp.float32)).astype(h.dtype)
    v = v.reshape(B, n, GMLP_CHUNK, GMLP_GROUPS, GMLP_GROUP_DIM)
    causal = jnp.tril(jnp.ones((GMLP_CHUNK, GMLP_CHUNK), dtype=bool))
    w = jnp.where(causal[None], w_s, 0.0)
    sv = jnp.einsum('gts,bnsgc->bntgc', w, v) + b_s.T[None, None, :, :, None]
    y = u * sv.reshape(B, S, D_GATE)
    return y @ w_o


def mixer_c(h, w_qkv, lam, subln_g, w_o, lambda_init):
    B, S, D = h.shape
    nb = S // Q_BLOCK
    q, k, v = jnp.split(h @ w_qkv, 3, axis=-1)
    q = q.reshape(B, nb, Q_BLOCK, HEADS_C, 2, HEAD_DIM_C).transpose(1, 0, 2, 3, 4, 5)
    k = k.reshape(B, S, HEADS_C, 2, HEAD_DIM_C)
    v = v.reshape(B, S, HEADS_C, 2 * HEAD_DIM_C)
    lamf = lam.astype(jnp.float32)
    lam_full = jnp.exp(jnp.sum(lamf[0] * lamf[1])) - jnp.exp(jnp.sum(lamf[2] * lamf[3])) + lambda_init
    slopes = 2.0 ** (-8.0 * (jnp.arange(HEADS_C, dtype=jnp.float32) + 1.0) / HEADS_C)
    kpos = jnp.arange(S)
    scale = HEAD_DIM_C ** -0.5

    def one_block(args):
        blk, qblk = args
        qpos = blk * Q_BLOCK + jnp.arange(Q_BLOCK)
        dist = jnp.abs(qpos[:, None] - kpos[None, :]).astype(jnp.float32)
        alibi = -slopes[:, None, None] * dist
        allowed = kpos[None, :] < (qpos[:, None] // CHUNK + 1) * CHUNK
        s = jnp.einsum('bqhmd,bkhmd->bmhqk', qblk, k).astype(jnp.float32) * scale + alibi
        s = jnp.where(allowed, s, NEG_INF)
        p = jax.nn.softmax(s, axis=-1)
        a = p[:, 0] - lam_full * p[:, 1]
        return jnp.einsum('bhqk,bkhe->bqhe', a.astype(v.dtype), v)

    o = lax.map(one_block, (jnp.arange(nb), q))
    o = o.transpose(1, 0, 2, 3, 4).reshape(B, S, HEADS_C, 2 * HEAD_DIM_C)
    o = rms_norm(o, subln_g) * (1.0 - lambda_init)
    return o.reshape(B, S, D) @ w_o


def setup_inputs(seed: int = 0) -> dict:
    key = jax.random.key(seed)
    ks = jax.random.split(key, 20)

    def nrm(k, shape, scale):
        return jax.random.normal(k, shape, jnp.float32) * scale

    D = D_MODEL
    return {
        'x': nrm(ks[0], (BATCH, SEQ, D), 1.0),
        'norm_g': 1.0 + nrm(ks[1], (DEPTH, 6, D), 0.05),
        'ff1_w_in': nrm(ks[2], (DEPTH, D, 2 * D_FF), D ** -0.5),
        'ff1_w_out': nrm(ks[3], (DEPTH, D_FF, D), D_FF ** -0.5),
        'ff2_w_in': nrm(ks[4], (DEPTH, D, 2 * D_FF), D ** -0.5),
        'ff2_w_out': nrm(ks[5], (DEPTH, D_FF, D), D_FF ** -0.5),
        'a_w_qkv': nrm(ks[6], (N_A, D, 3 * D), D ** -0.5),
        'a_rel_bias': nrm(ks[7], (N_A, HEADS_A, 2 * REL_CLIP + 1), 0.5),
        'a_w_o': nrm(ks[8], (N_A, D, D), D ** -0.5),
        'b_w_in': nrm(ks[9], (N_B, D, 2 * D_GATE), D ** -0.5),
        'b_ln_g': 1.0 + nrm(ks[10], (N_B, D_GATE), 0.05),
        'b_ln_b': nrm(ks[11], (N_B, D_GATE), 0.05),
        'b_w_s': nrm(ks[12], (N_B, GMLP_GROUPS, GMLP_CHUNK, GMLP_CHUNK), GMLP_CHUNK ** -0.5),
        'b_b_s': 1.0 + nrm(ks[13], (N_B, GMLP_GROUPS, GMLP_CHUNK), 0.1),
        'b_w_o': nrm(ks[14], (N_B, D_GATE, D), D_GATE ** -0.5),
        'c_w_qkv': nrm(ks[15], (N_C, D, 3 * D), D ** -0.5),
        'c_lambda': nrm(ks[16], (N_C, 4, HEAD_DIM_C), 0.1),
        'c_subln_g': 1.0 + nrm(ks[17], (N_C, 2 * HEAD_DIM_C), 0.05),
        'c_w_o': nrm(ks[18], (N_C, D, D), D ** -0.5),
    }


def reference(x, norm_g, ff1_w_in, ff1_w_out, ff2_w_in, ff2_w_out, a_w_qkv, a_rel_bias, a_w_o, b_w_in, b_ln_g, b_ln_b, b_w_s, b_b_s, b_w_o, c_w_qkv, c_lambda, c_subln_g, c_w_o):
    for i in range(DEPTH):
        g = norm_g[i]
        x = x + 0.5 * rms_norm(swiglu(rms_norm(x, g[0]), ff1_w_in[i], ff1_w_out[i]), g[1])
        h = rms_norm(x, g[2])
        kind, j = i % N_MIXERS, i // N_MIXERS
        if kind == 0:
            m = mixer_a(h, a_w_qkv[j], a_rel_bias[j], a_w_o[j])
        elif kind == 1:
            m = mixer_b(h, b_w_in[j], b_ln_g[j], b_ln_b[j], b_w_s[j], b_b_s[j], b_w_o[j])
        else:
            lambda_init = 0.8 - 0.6 * math.exp(-0.3 * i)
            m = mixer_c(h, c_w_qkv[j], c_lambda[j], c_subln_g[j], c_w_o[j], lambda_init)
        x = x + rms_norm(m, g[3])
        x = x + 0.5 * rms_norm(swiglu(rms_norm(x, g[4]), ff2_w_in[i], ff2_w_out[i]), g[5])
    return x
```

```cpp
#include <hip/hip_runtime.h>
#include <hip/hip_cooperative_groups.h>
#include <cstdio>
#include <cstdint>
#include <cmath>
namespace cg = cooperative_groups;
namespace pg8 {
#define PG8_LAS __attribute__((address_space(3)))
typedef unsigned short bf16_t;
typedef short bf16x8 __attribute__((ext_vector_type(8)));
typedef float f32x4 __attribute__((ext_vector_type(4)));
typedef unsigned u32x4 __attribute__((ext_vector_type(4)));
constexpr int BM = 256, BK = 64, HALF = 128, HTB = HALF * BK * 2  , STAGE_BYTES = 8 * HTB, NXCD = 8, WGM = 8;

__host__ __device__ __forceinline__ int lds_byte(int r, int c) { const int st = (r >> 4) * 2 + (c >> 5), rr = r & 15, cc = c & 31, ob = rr * 64 + cc * 2; return st * 1024 + (ob ^ (((ob >> 9) & 1) << 5)); }
__host__ __device__ __forceinline__ void stage_rc(int b, int& R, int& C) { const int st = b / 1024, sb = b % 1024, swz = sb ^ (((sb >> 9) & 1) << 5); R = (st >> 1) * 16 + swz / 64; C = (st & 1) * 32 + (swz % 64) / 2; }
__host__ __device__ __forceinline__ int perm32(int rho) { const int n = rho >> 4, i = rho & 15; return 8 * (i >> 2) + 4 * n + (i & 3); }

struct Unit { int pm, pn; };
struct Gemm { const bf16_t* A; const bf16_t* Bt; int M, N, K; };

struct StaticOrder {
    int nM, nN, nwg, G, c;
    __host__ __device__ void init(int M, int N, int G_, int c_) { nM = M / BM; nN = N / BM; nwg = nM * nN; G = G_; c = c_; }
    __host__ __device__ bool next(int i, Unit& u) const {
        const long L = (long)i * G + c; if (L >= nwg) return false;
        int wgid = (int)L; { const int q = nwg / NXCD, r = nwg % NXCD, xcd = wgid % NXCD, off = wgid / NXCD; wgid = (xcd < r ? xcd * (q + 1) : r * (q + 1) + (xcd - r) * q) + off; }
        const int nig = WGM * nN, gid = wgid / nig, fm = gid * WGM, gsz = (nM - fm) < WGM ? (nM - fm) : WGM;
        u.pm = fm + ((wgid % nig) % gsz); u.pn = (wgid % nig) / gsz; return true;
    }
    __device__ __forceinline__ void a_ready(const Unit&) const {}
    __device__ __forceinline__ void done(const Unit&) const {}
};

__device__ __forceinline__ unsigned cvt_pk_bf16(float lo, float hi) { unsigned r; asm volatile("v_cvt_pk_bf16_f32 %0, %1, %2" : "=v"(r) : "v"(lo), "v"(hi)); return r; }
typedef float f32x2 __attribute__((ext_vector_type(2)));
__device__ __forceinline__ f32x2 gelu_pk(f32x2 v) {
    const f32x2 av = __builtin_elementwise_abs(v), d = av * 0.2316418882f + 1.0f;
    f32x2 t; t.x = __builtin_amdgcn_rcpf(d.x); t.y = __builtin_amdgcn_rcpf(d.y);
    f32x2 q = t * 0.5307027145f + (-0.7265760135f); q = q * t + 0.7107068705f; q = q * t + (-0.142248368f); q = q * t + 0.127414796f; q = q * t;
    const f32x2 s = (v * v) * (-0.72134752044f);
    f32x2 e; e.x = __builtin_amdgcn_exp2f(s.x); e.y = __builtin_amdgcn_exp2f(s.y);
    const f32x2 m = v * (q * e), r = v - m;
    f32x2 o; o.x = v.x < 0.f ? m.x : r.x; o.y = v.y < 0.f ? m.y : r.y; return o;
}

template <int ACT  > struct EpiBf16 {
    static constexpr bool PERM = true, AFTER_DRAIN = false; static_assert(ACT == 0 || ACT == 1, "EpiBf16: ACT is 0 (none) or 1 (gelu_pk)");
    bf16_t* O; int ldc; const float* bias; int split_cols; size_t split_stride; float scale0;
    __device__ __forceinline__ void operator()(const f32x4 (&acc)[2][2][4][2], const Unit& u, int wr, int wc, int fr, int fq) const {
        const int row0 = u.pm * BM + wr * 64 + fr; int colt = u.pn * BM; bf16_t* base = O;
        float sc = 1.f; if (split_cols) { const int t = colt / split_cols; base += (size_t)t * split_stride; colt -= t * split_cols; if (t == 0) sc = scale0; }
        const int col0 = colt + wc * 32 + 8 * fq, bcol0 = u.pn * BM + wc * 32 + 8 * fq;
        f32x4 bv[2][2];
#pragma unroll
        for (int bj = 0; bj < 2; ++bj)
#pragma unroll
            for (int n = 0; n < 2; ++n) bv[bj][n] = bias ? *(const f32x4*)(bias + bcol0 + bj * HALF + 4 * n) : (f32x4){0.f, 0.f, 0.f, 0.f};
#pragma unroll
        for (int ai = 0; ai < 2; ++ai)
#pragma unroll
            for (int m = 0; m < 4; ++m) { bf16_t* rowp = base + (size_t)(row0 + ai * HALF + m * 16) * ldc + col0;
#pragma unroll
                for (int bj = 0; bj < 2; ++bj) { f32x4 v0 = acc[ai][bj][m][0] + bv[bj][0], v1 = acc[ai][bj][m][1] + bv[bj][1];
                    if (ACT == 1) { f32x2 a = gelu_pk((f32x2){v0[0], v0[1]}), b = gelu_pk((f32x2){v0[2], v0[3]}), c = gelu_pk((f32x2){v1[0], v1[1]}), d = gelu_pk((f32x2){v1[2], v1[3]});
                        v0 = (f32x4){a.x, a.y, b.x, b.y}; v1 = (f32x4){c.x, c.y, d.x, d.y}; }
                    v0 = v0 * sc; v1 = v1 * sc; u32x4 w; w.x = cvt_pk_bf16(v0[0], v0[1]); w.y = cvt_pk_bf16(v0[2], v0[3]); w.z = cvt_pk_bf16(v1[0], v1[1]); w.w = cvt_pk_bf16(v1[2], v1[3]);
                    *(u32x4*)(rowp + bj * HALF) = w; } }
    }
};
struct EpiSwiGLU {
    static constexpr bool PERM = true, AFTER_DRAIN = false;
    bf16_t* O; int ldc;
    __device__ __forceinline__ void operator()(const f32x4 (&acc)[2][2][4][2], const Unit& u, int wr, int wc, int fr, int fq) const {
        const int row0 = u.pm * BM + wr * 64 + fr, col0 = u.pn * HALF + wc * 32 + 8 * fq;
#pragma unroll
        for (int ai = 0; ai < 2; ++ai)
#pragma unroll
            for (int m = 0; m < 4; ++m) {
                bf16_t* rowp = O + (size_t)(row0 + ai * HALF + m * 16) * ldc + col0;
                float v[8];
#pragma unroll
                for (int n = 0; n < 2; ++n)
#pragma unroll
                    for (int e = 0; e < 4; ++e) {
                        const float g = acc[ai][0][m][n][e], up = acc[ai][1][m][n][e];
                        const float sg = g * __builtin_amdgcn_rcpf(1.0f + __builtin_amdgcn_exp2f(-1.4426950408889634f * g));
                        v[n * 4 + e] = sg * up;
                    }
                u32x4 w; w.x = cvt_pk_bf16(v[0], v[1]); w.y = cvt_pk_bf16(v[2], v[3]); w.z = cvt_pk_bf16(v[4], v[5]); w.w = cvt_pk_bf16(v[6], v[7]);
                *(u32x4*)rowp = w;
            }
    }
};
struct EpiF32 {
    static constexpr bool PERM = false, AFTER_DRAIN = false;
    float* O; int ldc;
    __device__ __forceinline__ void operator()(const f32x4 (&acc)[2][2][4][2], const Unit& u, int wr, int wc, int fr, int fq) const {
        const int row0 = u.pm * BM + wr * 64 + fr, col0 = u.pn * BM + wc * 32 + 4 * fq;
#pragma unroll
        for (int ai = 0; ai < 2; ++ai)
#pragma unroll
            for (int m = 0; m < 4; ++m) {
                float* rowp = O + (size_t)(row0 + ai * HALF + m * 16) * ldc + col0;
#pragma unroll
                for (int bj = 0; bj < 2; ++bj)
#pragma unroll
                    for (int n = 0; n < 2; ++n) *(f32x4*)(rowp + bj * HALF + n * 16) = acc[ai][bj][m][n];
            }
    }
};
template <class Epi, class Sched, bool ALIGN_EPI = false, bool SP2 = false>
__device__ __forceinline__ void gemm_phase(PG8_LAS unsigned char* lds, const Gemm g, const Sched& S, const Epi& E) {
    int tid_o = threadIdx.x; asm volatile("" : "+v"(tid_o)); const int tid = tid_o, wid = __builtin_amdgcn_readfirstlane(tid >> 6), lane = tid & 63, wr = wid >> 2, wc = wid & 3, fr = lane & 15, fq = lane >> 4;
    const int K = g.K, nt = K / BK;
    unsigned voffA[2], voffB[2];
#pragma unroll
    for (int i = 0; i < 2; ++i) { int R, C; stage_rc(tid * 16 + i * 8192, R, C); const int Rb = Epi::PERM ? ((R & ~31) + perm32(R & 31)) : R;
        voffA[i] = (unsigned)(R * K + C) * 2u; voffB[i] = (unsigned)(Rb * K + C) * 2u; }
    const size_t kstep = (size_t)(BK * 2);
    const size_t hstep = (size_t)HALF * K * 2;
    const size_t tstep = 2 * hstep;
    const unsigned ldsw = (unsigned)wid * 1024u;
    const int aoff = lds_byte(wr * 64 + fr, fq * 8), boff = lds_byte(wc * 32 + fr, fq * 8);
#define PG8_SA(b, h) (((b) * 2 + (h)) * HTB)
#define PG8_SB(b, h) ((4 + (b) * 2 + (h)) * HTB)
#define PG8_STAGE(bufoff, gbase, voff) do { _Pragma("unroll") for (int _i = 0; _i < 2; ++_i) \
        __builtin_amdgcn_global_load_lds((const unsigned*)((const char*)(gbase) + (voff)[_i]), (PG8_LAS unsigned*)(lds + (bufoff) + ldsw + _i * 8192), 16, 0, 0); } while (0)
#define PG8_LDA(dst, b, h) do { _Pragma("unroll") for (int m = 0; m < 4; ++m) _Pragma("unroll") for (int k = 0; k < 2; ++k) dst[m][k] = *(const PG8_LAS bf16x8*)(lds + PG8_SA(b, h) + aoff + m * 2048 + k * 1024); } while (0)
#define PG8_LDB(dst, b, h) do { _Pragma("unroll") for (int n = 0; n < 2; ++n) _Pragma("unroll") for (int k = 0; k < 2; ++k) dst[n][k] = *(const PG8_LAS bf16x8*)(lds + PG8_SB(b, h) + boff + n * 2048 + k * 1024); } while (0)
#define PG8_MMA(ai, bj, At, Bt) do { __builtin_amdgcn_s_setprio(1); _Pragma("unroll") for (int m = 0; m < 4; ++m) _Pragma("unroll") for (int n = 0; n < 2; ++n) _Pragma("unroll") for (int k = 0; k < 2; ++k) \
        acc[ai][bj][m][n] = __builtin_amdgcn_mfma_f32_16x16x32_bf16(Bt[n][k], At[m][k], acc[ai][bj][m][n], 0, 0, 0); __builtin_amdgcn_s_setprio(0); } while (0)
#define PG8_WAIT_V(n) asm volatile("s_waitcnt vmcnt(" #n ")" ::: "memory")
#define PG8_WAIT_L(n) asm volatile("s_waitcnt lgkmcnt(" #n ")" ::: "memory")
#define PG8_BAR __builtin_amdgcn_s_barrier()
#define PG8_SCHED __builtin_amdgcn_sched_barrier(0)
    Unit cur, nxt; int ui = 0;
    if (!S.next(0, cur)) return;
    f32x4 acc[2][2][4][2];
#pragma unroll
    for (int a = 0; a < 2; ++a)
#pragma unroll
        for (int b = 0; b < 2; ++b)
#pragma unroll
            for (int m = 0; m < 4; ++m)
#pragma unroll
                for (int n = 0; n < 2; ++n) acc[a][b][m][n] = (f32x4){0.f, 0.f, 0.f, 0.f};
    bf16x8 At[4][2], B0[2][2], B1[2][2];
    const char* cA = (const char*)g.A + (size_t)cur.pm * tstep; const char* cB = (const char*)g.Bt + (size_t)cur.pn * tstep;
    S.a_ready(cur);
    if constexpr (SP2) {
        PG8_STAGE(PG8_SB(0, 0), cB, voffB); PG8_STAGE(PG8_SB(0, 1), cB + hstep, voffB); PG8_STAGE(PG8_SA(0, 0), cA, voffA); PG8_STAGE(PG8_SA(0, 1), cA + hstep, voffA);
        if (wr == 1) PG8_BAR;
        PG8_WAIT_V(2); PG8_BAR;
        PG8_STAGE(PG8_SB(1, 0), cB + kstep, voffB); PG8_STAGE(PG8_SA(1, 0), cA + kstep, voffA); PG8_STAGE(PG8_SB(1, 1), cB + hstep + kstep, voffB);
        PG8_WAIT_V(6); PG8_BAR;
    } else {
        PG8_STAGE(PG8_SB(0, 0), cB, voffB); PG8_STAGE(PG8_SA(0, 0), cA, voffA); PG8_STAGE(PG8_SB(0, 1), cB + hstep, voffB); PG8_STAGE(PG8_SA(0, 1), cA + hstep, voffA);
        if (wr == 1) PG8_BAR;
        PG8_WAIT_V(4); PG8_BAR;
        PG8_STAGE(PG8_SB(1, 0), cB + kstep, voffB); PG8_STAGE(PG8_SA(1, 0), cA + kstep, voffA); PG8_STAGE(PG8_SB(1, 1), cB + hstep + kstep, voffB);
        PG8_WAIT_V(6); PG8_BAR;
    }
    for (;;) {
        const bool has_next = S.next(ui + 1, nxt);
        const char* nA = has_next ? (const char*)g.A + (size_t)nxt.pm * tstep : cA; const char* nB = has_next ? (const char*)g.Bt + (size_t)nxt.pn * tstep : cB;
        for (int t = 0; t < nt; t += 2) {
            const bool last = (t == nt - 2);
            const char* a1 = cA + (size_t)(t + 1) * kstep;
            const char* a2 = last ? nA : cA + (size_t)(t + 2) * kstep; const char* b2 = last ? nB : cB + (size_t)(t + 2) * kstep;
            const char* a3 = a2 + kstep; const char* b3 = b2 + kstep;
            if (last && has_next) S.a_ready(nxt);
            if constexpr (SP2) {
            PG8_LDB(B0, 0, 0); PG8_LDB(B1, 0, 1); PG8_SCHED; PG8_LDA(At, 0, 0); PG8_STAGE(PG8_SA(1, 1), a1 + hstep, voffA);
            PG8_WAIT_V(8); PG8_WAIT_L(0); PG8_BAR; PG8_MMA(0, 0, At, B0); PG8_MMA(0, 1, At, B1); PG8_BAR; PG8_SCHED;
            PG8_LDA(At, 0, 1); PG8_STAGE(PG8_SB(0, 0), b2, voffB); PG8_STAGE(PG8_SB(0, 1), b2 + hstep, voffB); PG8_STAGE(PG8_SA(0, 0), a2, voffA);
            PG8_WAIT_V(8); PG8_WAIT_L(0); PG8_BAR; PG8_MMA(1, 0, At, B0); PG8_MMA(1, 1, At, B1); PG8_BAR; PG8_SCHED;
            PG8_LDB(B0, 1, 0); PG8_LDB(B1, 1, 1); PG8_SCHED; PG8_LDA(At, 1, 0); PG8_STAGE(PG8_SA(0, 1), a2 + hstep, voffA);
            PG8_WAIT_V(8); PG8_WAIT_L(0); PG8_BAR; PG8_MMA(0, 0, At, B0); PG8_MMA(0, 1, At, B1); PG8_BAR; PG8_SCHED;
            PG8_LDA(At, 1, 1); PG8_STAGE(PG8_SB(1, 0), b3, voffB); PG8_STAGE(PG8_SB(1, 1), b3 + hstep, voffB); PG8_STAGE(PG8_SA(1, 0), a3, voffA);
            PG8_WAIT_V(8); PG8_WAIT_L(0); PG8_BAR; PG8_MMA(1, 0, At, B0); PG8_MMA(1, 1, At, B1); PG8_BAR; PG8_SCHED;
            } else {
            PG8_LDB(B0, 0, 0); PG8_SCHED; PG8_LDA(At, 0, 0); PG8_STAGE(PG8_SA(1, 1), a1 + hstep, voffA);
            PG8_WAIT_L(8); PG8_BAR; PG8_WAIT_L(0); PG8_MMA(0, 0, At, B0); PG8_BAR; PG8_SCHED;
            PG8_LDB(B1, 0, 1); PG8_STAGE(PG8_SB(0, 0), b2, voffB);
            PG8_BAR; PG8_WAIT_L(0); PG8_MMA(0, 1, At, B1); PG8_BAR;
            PG8_LDA(At, 0, 1); PG8_STAGE(PG8_SA(0, 0), a2, voffA);
            PG8_BAR; PG8_WAIT_L(0); PG8_MMA(1, 0, At, B0); PG8_BAR; PG8_SCHED;
            PG8_STAGE(PG8_SB(0, 1), b2 + hstep, voffB);
            PG8_WAIT_V(6); PG8_BAR; PG8_MMA(1, 1, At, B1); PG8_BAR;
            PG8_LDB(B0, 1, 0); PG8_SCHED; PG8_LDA(At, 1, 0); PG8_STAGE(PG8_SA(0, 1), a2 + hstep, voffA);
            PG8_WAIT_L(8); PG8_BAR; PG8_WAIT_L(0); PG8_MMA(0, 0, At, B0); PG8_BAR; PG8_SCHED;
            PG8_LDB(B1, 1, 1); PG8_STAGE(PG8_SB(1, 0), b3, voffB);
            PG8_BAR; PG8_WAIT_L(0); PG8_MMA(0, 1, At, B1); PG8_BAR;
            PG8_LDA(At, 1, 1); PG8_STAGE(PG8_SA(1, 0), a3, voffA);
            PG8_BAR; PG8_WAIT_L(0); PG8_MMA(1, 0, At, B0); PG8_BAR; PG8_SCHED;
            PG8_STAGE(PG8_SB(1, 1), b3 + hstep, voffB);
            PG8_WAIT_V(6); PG8_BAR; PG8_MMA(1, 1, At, B1); PG8_BAR;
            }
        }
        if constexpr (ALIGN_EPI) { if (wr == 0) PG8_BAR; }
        if constexpr (!Epi::AFTER_DRAIN) { E(acc, cur, wr, wc, fr, fq); S.done(cur); }
        if (!has_next) break;
#pragma unroll
        for (int a = 0; a < 2; ++a)
#pragma unroll
            for (int b = 0; b < 2; ++b)
#pragma unroll
                for (int m = 0; m < 4; ++m)
#pragma unroll
                    for (int n = 0; n < 2; ++n) acc[a][b][m][n] = (f32x4){0.f, 0.f, 0.f, 0.f};
        cur = nxt; cA = nA; cB = nB; ++ui;
        if constexpr (ALIGN_EPI) { if (wr == 1) PG8_BAR; }
    }
    PG8_WAIT_V(0);
    if constexpr (!ALIGN_EPI) { if (wr == 0) PG8_BAR; }
    PG8_BAR;
    if constexpr (Epi::AFTER_DRAIN) { E.fused(acc, cur, wr, wc, fr, fq, lds, wid, lane); S.done(cur); }
#undef PG8_SA
#undef PG8_SB
#undef PG8_STAGE
#undef PG8_LDA
#undef PG8_LDB
#undef PG8_MMA
#undef PG8_WAIT_V
#undef PG8_WAIT_L
#undef PG8_BAR
#undef PG8_SCHED
}
}
#define LAS __attribute__((address_space(3)))
typedef unsigned short bf16;
typedef short bf16x8 __attribute__((ext_vector_type(8)));
typedef short s16x4 __attribute__((ext_vector_type(4)));
typedef float f32x4 __attribute__((ext_vector_type(4)));
typedef float f32x16 __attribute__((ext_vector_type(16)));
typedef unsigned u32x4 __attribute__((ext_vector_type(4)));
typedef unsigned u32x2 __attribute__((ext_vector_type(2)));

constexpr int M = 16384, D = 1024, S = 8192, DFF = 2816, NLAYER = 4;
constexpr float EPS = 1e-6f, LOG2E = 1.4426950408889634f;
constexpr size_t MiB = 1u << 20;
constexpr size_t WS_W = 1 * MiB;
constexpr size_t WS_WA = WS_W + 132 * MiB;
constexpr size_t WS_WB = WS_WA + 16 * MiB;
constexpr size_t WS_WC = WS_WB + 7 * MiB;
constexpr size_t WS_H = WS_WC + 8 * MiB;
constexpr size_t WS_BIG = WS_H + 32 * MiB;
constexpr size_t WS_Y = WS_BIG + 96 * MiB;
constexpr size_t WS_END = WS_Y + 64 * MiB;
constexpr int LDS_BYTES = 147456;

struct Params {
    const float* in[19];
    float* out;
    unsigned char* ws;
    float lam_init;
    int ph_lo, ph_hi, coop;
};

__device__ __forceinline__ int otid() { int t = threadIdx.x; asm volatile("" : "+v"(t)); return t; }
__device__ __forceinline__ float bf2f(unsigned short v) { return __builtin_bit_cast(float, (unsigned)v << 16); }
__device__ __forceinline__ unsigned pk2(float lo, float hi) { return pg8::cvt_pk_bf16(lo, hi); }
__device__ __forceinline__ float wave_sum(float v) {
#pragma unroll
    for (int o = 1; o < 64; o <<= 1) v += __shfl_xor(v, o);
    return v;
}

__device__ __forceinline__ void transpose_item(const float* __restrict__ W, int K, int N, bf16* __restrict__ WT, int swiglu, LAS float* scr, int item, int lane) {
    const int nblk = N / 64, kb = item / nblk, nb = item % nblk, k0 = 64 * kb, n0 = 64 * nb;
#pragma unroll 4
    for (int i = 0; i < 16; ++i) {
        const int kk = 4 * i + (lane >> 4);
        const f32x4 v = *(const f32x4*)(W + (size_t)(k0 + kk) * N + n0 + 4 * (lane & 15));
        LAS float* s = scr + kk * 65 + 4 * (lane & 15);
        s[0] = v.x; s[1] = v.y; s[2] = v.z; s[3] = v.w;
    }
    asm volatile("s_waitcnt lgkmcnt(0)" ::: "memory");
    const int c = lane & 7;
#pragma unroll
    for (int j = 0; j < 8; ++j) {
        const int n = (lane >> 3) + 8 * j;
        const LAS float* s = scr + (8 * c) * 65 + n;
        u32x4 o; o.x = pk2(s[0], s[65]); o.y = pk2(s[2 * 65], s[3 * 65]); o.z = pk2(s[4 * 65], s[5 * 65]); o.w = pk2(s[6 * 65], s[7 * 65]);
        const int nn = n0 + n;
        int row = nn;
        if (swiglu) { row = (nn < DFF) ? ((nn >> 7) * 256 + (nn & 127)) : ((((nn - DFF) >> 7) * 256) + 128 + ((nn - DFF) & 127)); }
        *(u32x4*)(WT + (size_t)row * K + k0 + 8 * c) = o;
    }
    asm volatile("s_waitcnt lgkmcnt(0)" ::: "memory");
}

struct MatDesc { const float* W; bf16* WT; int K, N, swiglu; };
__device__ __forceinline__ MatDesc get_mat(const Params& P, int mi) {
    MatDesc d; unsigned char* ws = P.ws;
    if (mi < 16) {
        const int L = mi >> 2, w = mi & 3;
        unsigned char* base = ws + WS_W + (size_t)L * 33 * MiB;
        if (w == 0)      { d.W = P.in[2] + (size_t)L * D * 2 * DFF; d.WT = (bf16*)base; d.K = D; d.N = 2 * DFF; d.swiglu = 1; }
        else if (w == 1) { d.W = P.in[3] + (size_t)L * DFF * D; d.WT = (bf16*)(base + 11 * MiB); d.K = DFF; d.N = D; d.swiglu = 0; }
        else if (w == 2) { d.W = P.in[4] + (size_t)L * D * 2 * DFF; d.WT = (bf16*)(base + 16 * MiB + MiB / 2); d.K = D; d.N = 2 * DFF; d.swiglu = 1; }
        else             { d.W = P.in[5] + (size_t)L * DFF * D; d.WT = (bf16*)(base + 27 * MiB + MiB / 2); d.K = DFF; d.N = D; d.swiglu = 0; }
    } else if (mi < 20) {
        const int j = (mi - 16) >> 1, w = (mi - 16) & 1;
        unsigned char* base = ws + WS_WA + (size_t)j * 8 * MiB;
        if (w == 0) { d.W = P.in[6] + (size_t)j * D * 3 * D; d.WT = (bf16*)base; d.K = D; d.N = 3 * D; d.swiglu = 0; }
        else        { d.W = P.in[8] + (size_t)j * D * D; d.WT = (bf16*)(base + 6 * MiB); d.K = D; d.N = D; d.swiglu = 0; }
    } else if (mi < 22) {
        if (mi == 20) { d.W = P.in[9]; d.WT = (bf16*)(ws + WS_WB); d.K = D; d.N = 2 * D; d.swiglu = 0; }
        else          { d.W = P.in[14]; d.WT = (bf16*)(ws + WS_WB + 4 * MiB); d.K = D; d.N = D; d.swiglu = 0; }
    } else {
        if (mi == 22) { d.W = P.in[15]; d.WT = (bf16*)(ws + WS_WC); d.K = D; d.N = 3 * D; d.swiglu = 0; }
        else          { d.W = P.in[18]; d.WT = (bf16*)(ws + WS_WC + 6 * MiB); d.K = D; d.N = D; d.swiglu = 0; }
    }
    return d;
}

__device__ __forceinline__ void norm_phase(const float* xin, const float* y, float coef, const float* gpost, const float* gpre, float* xout, bf16* h, int gw, int ngw, int lane) {
    for (int row = gw; row < M; row += ngw) {
        const f32x4* xr = (const f32x4*)(xin + (size_t)row * D) + lane;
        f32x4 v[4];
#pragma unroll
        for (int j = 0; j < 4; ++j) v[j] = xr[64 * j];
        if (y) {
            const f32x4* yr = (const f32x4*)(y + (size_t)row * D) + lane;
            f32x4 yv[4]; float ss = 0.f;
#pragma unroll
            for (int j = 0; j < 4; ++j) { yv[j] = yr[64 * j]; ss += (yv[j].x * yv[j].x + yv[j].y * yv[j].y) + (yv[j].z * yv[j].z + yv[j].w * yv[j].w); }
            const float rs = coef / sqrtf(wave_sum(ss) * (1.0f / D) + EPS);
#pragma unroll
            for (int j = 0; j < 4; ++j) { const f32x4 g = ((const f32x4*)gpost)[lane + 64 * j]; v[j] += yv[j] * rs * g; }
        }
        if (xout) {
            f32x4* xo = (f32x4*)(xout + (size_t)row * D) + lane;
#pragma unroll
            for (int j = 0; j < 4; ++j) xo[64 * j] = v[j];
        }
        if (h) {
            float ss = 0.f;
#pragma unroll
            for (int j = 0; j < 4; ++j) ss += (v[j].x * v[j].x + v[j].y * v[j].y) + (v[j].z * v[j].z + v[j].w * v[j].w);
            const float rs = 1.0f / sqrtf(wave_sum(ss) * (1.0f / D) + EPS);
            u32x2* ho = (u32x2*)(h + (size_t)row * D) + lane;
#pragma unroll
            for (int j = 0; j < 4; ++j) { const f32x4 g = ((const f32x4*)gpre)[lane + 64 * j]; const f32x4 o = v[j] * rs * g; u32x2 w; w.x = pk2(o.x, o.y); w.y = pk2(o.z, o.w); ho[64 * j] = w; }
        }
    }
}

namespace att {
constexpr int KP = 144;
template <int DV> struct L { static constexpr int VP = DV * 2 + 64, KB = 64 * KP, VB = 64 * VP, BUF = KB + VB; };
typedef short v4i16_t __attribute__((ext_vector_type(4)));
__device__ __forceinline__ s16x4 vtr(const LAS unsigned char* p) { return __builtin_bit_cast(s16x4, __builtin_amdgcn_ds_read_tr16_b64_v4i16((LAS v4i16_t*)p)); }
__device__ __forceinline__ bf16x8 pack8(const f32x16& p, int b) {
    u32x4 w; w.x = pk2(p[b], p[b + 1]); w.y = pk2(p[b + 2], p[b + 3]); w.z = pk2(p[b + 4], p[b + 5]); w.w = pk2(p[b + 6], p[b + 7]);
    return __builtin_bit_cast(bf16x8, w);
}
template <int DV, int MODE>
__device__ __forceinline__ void stream(LAS unsigned char* lds, const bf16* __restrict__ Kg, const bf16* __restrict__ Vg, int T0, int T1, int wlo, int whi,
                                       const bf16x8 (&qr)[4], int qw0, float slope2, const LAS float* tbl, f32x16 (&o)[DV / 32], float& m, float& l) {
    constexpr int VP = L<DV>::VP, KB = L<DV>::KB, BUF = L<DV>::BUF, NV = DV / 64, VCH = DV / 8;
    const int tid = otid(), lane = tid & 63, r32 = lane & 31, hi = lane >> 5;
    const int krow = tid >> 3, kch = tid & 7;
    u32x4 kreg; u32x4 vreg[NV];
#define ATT_GLOAD(t) do { kreg = *(const u32x4*)(Kg + (size_t)(64 * (t) + krow) * 1024 + kch * 8); \
        _Pragma("unroll") for (int i_ = 0; i_ < NV; ++i_) { const int idx_ = tid + 512 * i_; const int vr_ = idx_ / VCH, vc_ = idx_ % VCH; \
            vreg[i_] = *(const u32x4*)(Vg + (size_t)(64 * (t) + vr_) * 1024 + vc_ * 8); } } while (0)
#define ATT_LSTORE(buf) do { *(LAS u32x4*)(lds + (buf) * BUF + krow * KP + kch * 16) = kreg; \
        _Pragma("unroll") for (int i_ = 0; i_ < NV; ++i_) { const int idx_ = tid + 512 * i_; const int vr_ = idx_ / VCH, vc_ = idx_ % VCH; \
            *(LAS u32x4*)(lds + (buf) * BUF + KB + vr_ * VP + vc_ * 16) = vreg[i_]; } } while (0)
    ATT_GLOAD(T0); ATT_LSTORE(0); __syncthreads();
    const int g4 = lane >> 4, i16 = lane & 15;
    const int voff = (4 * (g4 >> 1) + (i16 >> 2)) * VP + (16 * (g4 & 1) + 4 * (i16 & 3)) * 2;
    for (int t = T0; t < T1; ++t) {
        const int cur = (t - T0) & 1; const bool more = (t + 1 < T1);
        if (more) ATT_GLOAD(t + 1);
        if (t >= wlo && t <= whi) {
            const LAS unsigned char* Kl = lds + cur * BUF; const LAS unsigned char* Vl = Kl + KB;
            f32x16 p0 = {}, p1 = {};
#pragma unroll
            for (int d0 = 0; d0 < 4; ++d0) {
                const bf16x8 b0 = *(const LAS bf16x8*)(Kl + r32 * KP + d0 * 32 + hi * 16);
                const bf16x8 b1 = *(const LAS bf16x8*)(Kl + (32 + r32) * KP + d0 * 32 + hi * 16);
                p0 = __builtin_amdgcn_mfma_f32_32x32x16_bf16(b0, qr[d0], p0, 0, 0, 0);
                p1 = __builtin_amdgcn_mfma_f32_32x32x16_bf16(b1, qr[d0], p1, 0, 0, 0);
            }
            if (MODE == 1) {
                const float dq = (float)(qw0 + r32 - 64 * t - 4 * hi);
#pragma unroll
                for (int r = 0; r < 16; ++r) { const float c = (float)((r & 3) + 8 * (r >> 2));
                    p0[r] = __builtin_fmaf(-slope2, __builtin_fabsf(dq - c), p0[r]); p1[r] = __builtin_fmaf(-slope2, __builtin_fabsf(dq - (c + 32.0f)), p1[r]); }
            } else {
                if (qw0 - (64 * t + 63) >= 128) { const float c = tbl[256];
#pragma unroll
                    for (int r = 0; r < 16; ++r) { p0[r] += c; p1[r] += c; }
                } else { const int dq = qw0 + r32 - 64 * t - 4 * hi + 128;
#pragma unroll
                    for (int r = 0; r < 16; ++r) { const int c = (r & 3) + 8 * (r >> 2);
                        int i0 = dq - c; i0 = i0 < 0 ? 0 : (i0 > 256 ? 256 : i0); int i1 = dq - c - 32; i1 = i1 < 0 ? 0 : (i1 > 256 ? 256 : i1);
                        p0[r] += tbl[i0]; p1[r] += tbl[i1]; }
                }
            }
            float mx = __builtin_fmaxf(p0[0], p1[0]);
#pragma unroll
            for (int r = 1; r < 16; ++r) mx = __builtin_fmaxf(mx, __builtin_fmaxf(p0[r], p1[r]));
            mx = __builtin_fmaxf(mx, __shfl_xor(mx, 32));
            if (__any(mx > m)) {
                const float mn = __builtin_fmaxf(m, mx); const float f = __builtin_amdgcn_exp2f(m - mn); m = mn; l *= f;
#pragma unroll
                for (int db = 0; db < DV / 32; ++db) o[db] *= f;
            }
            float ls = 0.f;
#pragma unroll
            for (int r = 0; r < 16; ++r) { p0[r] = __builtin_amdgcn_exp2f(p0[r] - m); p1[r] = __builtin_amdgcn_exp2f(p1[r] - m); ls += p0[r] + p1[r]; }
            l += ls;
            bf16x8 pa[4]; pa[0] = pack8(p0, 0); pa[1] = pack8(p0, 8); pa[2] = pack8(p1, 0); pa[3] = pack8(p1, 8);
            const LAS unsigned char* vb = Vl + voff;
#pragma unroll
            for (int db = 0; db < DV / 32; ++db)
#pragma unroll
                for (int s = 0; s < 4; ++s) {
                    const s16x4 lo = vtr(vb + (16 * s) * VP + db * 64), hh = vtr(vb + (16 * s + 8) * VP + db * 64);
                    const bf16x8 vf = (bf16x8){lo[0], lo[1], lo[2], lo[3], hh[0], hh[1], hh[2], hh[3]};
                    o[db] = __builtin_amdgcn_mfma_f32_32x32x16_bf16(vf, pa[s], o[db], 0, 0, 0);
                }
        }
        if (more) ATT_LSTORE(cur ^ 1);
        __syncthreads();
    }
#undef ATT_GLOAD
#undef ATT_LSTORE
}

__device__ __forceinline__ void unit_a(LAS unsigned char* lds, const bf16* Q, const bf16* K, const bf16* V, bf16* O, const float* relb, int b, int h, int qb) {
    const int tid = otid(), lane = tid & 63, r32 = lane & 31, hi = lane >> 5, wid = __builtin_amdgcn_readfirstlane(tid >> 6);
    LAS float* tbl = (LAS float*)(lds + 2 * L<64>::BUF);
    for (int i = tid; i < 257; i += 512) tbl[i] = relb[h * 257 + i] * LOG2E;
    const size_t rowbase = (size_t)b * S; const int qw0 = 256 * qb + 32 * wid, qpos = qw0 + r32;
    bf16x8 qr[4];
    const bf16* qp = Q + (rowbase + qpos) * 1024 + h * 64 + hi * 8;
#pragma unroll
    for (int d0 = 0; d0 < 4; ++d0) qr[d0] = *(const bf16x8*)(qp + d0 * 16);
    const int cw = qw0 >> 6; const int wlo = cw - 8 < 0 ? 0 : cw - 8, whi = cw;
    const int T0 = 4 * qb - 8 < 0 ? 0 : 4 * qb - 8, T1 = 4 * qb + 4;
    f32x16 o[2]; o[0] = f32x16{}; o[1] = f32x16{}; float m = -1e30f, l = 0.f;
    stream<64, 0>(lds, K + rowbase * 1024 + h * 64, V + rowbase * 1024 + h * 64, T0, T1, wlo, whi, qr, qw0, 0.f, tbl, o, m, l);
    l += __shfl_xor(l, 32); const float inv = 1.0f / l;
    bf16* op = O + (rowbase + qpos) * 1024 + h * 64 + 4 * hi;
#pragma unroll
    for (int db = 0; db < 2; ++db)
#pragma unroll
        for (int rr = 0; rr < 4; ++rr) { u32x2 w; w.x = pk2(o[db][4 * rr] * inv, o[db][4 * rr + 1] * inv); w.y = pk2(o[db][4 * rr + 2] * inv, o[db][4 * rr + 3] * inv);
            *(u32x2*)(op + 32 * db + 8 * rr) = w; }
}

__device__ __forceinline__ void unit_c(LAS unsigned char* lds, const bf16* Q, const bf16* K, const bf16* V, bf16* O, float* keepbuf, float lam_full, const float* subg, float lam_init, int b, int h, int qb) {
    const int tid = otid(), lane = tid & 63, r32 = lane & 31, hi = lane >> 5, wid = __builtin_amdgcn_readfirstlane(tid >> 6);
    const size_t rowbase = (size_t)b * S; const int qw0 = 256 * qb + 32 * wid, qpos = qw0 + r32;
    const int whi = qw0 >> 6, T1 = 4 * qb + 4;
    float* kp = keepbuf + (rowbase + qpos) * 1024 + h * 128 + 4 * hi;
    const float slope2 = __builtin_amdgcn_exp2f(-(float)(h + 1)) * LOG2E;
    f32x16 o[4];
#pragma unroll 1
    for (int mp = 0; mp < 2; ++mp) {
        bf16x8 qr[4];
        const bf16* qp = Q + (rowbase + qpos) * 1024 + h * 128 + mp * 64 + hi * 8;
#pragma unroll
        for (int d0 = 0; d0 < 4; ++d0) qr[d0] = *(const bf16x8*)(qp + d0 * 16);
#pragma unroll
        for (int db = 0; db < 4; ++db) o[db] = f32x16{};
        float m = -1e30f, l = 0.f;
        stream<128, 1>(lds, K + rowbase * 1024 + h * 128 + mp * 64, V + rowbase * 1024 + h * 128, 0, T1, 0, whi, qr, qw0, slope2, nullptr, o, m, l);
        l += __shfl_xor(l, 32); const float inv = 1.0f / l;
        if (mp == 0) {
#pragma unroll
            for (int db = 0; db < 4; ++db)
#pragma unroll
                for (int rr = 0; rr < 4; ++rr) *(f32x4*)(kp + 32 * db + 8 * rr) = (f32x4){o[db][4 * rr] * inv, o[db][4 * rr + 1] * inv, o[db][4 * rr + 2] * inv, o[db][4 * rr + 3] * inv};
        } else {
            const float c = lam_full * inv;
#pragma unroll
            for (int db = 0; db < 4; ++db)
#pragma unroll
                for (int rr = 0; rr < 4; ++rr) { const f32x4 k4 = *(const f32x4*)(kp + 32 * db + 8 * rr);
                    o[db][4 * rr] = k4.x - o[db][4 * rr] * c; o[db][4 * rr + 1] = k4.y - o[db][4 * rr + 1] * c; o[db][4 * rr + 2] = k4.z - o[db][4 * rr + 2] * c; o[db][4 * rr + 3] = k4.w - o[db][4 * rr + 3] * c; }
        }
    }
    float ss = 0.f;
#pragma unroll
    for (int db = 0; db < 4; ++db)
#pragma unroll
        for (int r = 0; r < 16; ++r) ss += o[db][r] * o[db][r];
    ss += __shfl_xor(ss, 32);
    const float rs = (1.0f - lam_init) / sqrtf(ss * (1.0f / 128.0f) + EPS);
    bf16* op = O + (rowbase + qpos) * 1024 + h * 128 + 4 * hi;
#pragma unroll
    for (int db = 0; db < 4; ++db)
#pragma unroll
        for (int rr = 0; rr < 4; ++rr) { const f32x4 g = *(const f32x4*)(subg + 32 * db + 8 * rr + 4 * hi);
            u32x2 w; w.x = pk2(o[db][4 * rr] * rs * g.x, o[db][4 * rr + 1] * rs * g.y); w.y = pk2(o[db][4 * rr + 2] * rs * g.z, o[db][4 * rr + 3] * rs * g.w);
            *(u32x2*)(op + 32 * db + 8 * rr) = w; }
}
}

__device__ __forceinline__ void spatial_unit(LAS unsigned char* lds, const bf16* UV, bf16* Yb, const float* lng, const float* lnb, const bf16* wsb, const float* bs, int unit) {
    const int tid = otid(), lane = tid & 63, r32 = lane & 31, hi = lane >> 5, wid = __builtin_amdgcn_readfirstlane(tid >> 6);
    const int chunk = unit >> 1, half = unit & 1; const size_t row0 = (size_t)chunk * 128;
    LAS float* st = (LAS float*)lds;
    LAS unsigned char* vt = lds + 1024;
    for (int rr = 0; rr < 16; ++rr) {
        const int row = 16 * wid + rr;
        const bf16* vp = UV + (row0 + row) * 2048 + 1024 + lane * 16;
        const u32x4 a = *(const u32x4*)vp, b2 = *(const u32x4*)(vp + 8);
        float s = 0.f, ss = 0.f;
#pragma unroll
        for (int e = 0; e < 4; ++e) { const float x0 = __builtin_bit_cast(float, a[e] << 16), x1 = __builtin_bit_cast(float, a[e] & 0xffff0000u), y0 = __builtin_bit_cast(float, b2[e] << 16), y1 = __builtin_bit_cast(float, b2[e] & 0xffff0000u);
            s += (x0 + x1) + (y0 + y1); ss += (x0 * x0 + x1 * x1) + (y0 * y0 + y1 * y1); }
        s = wave_sum(s); ss = wave_sum(ss);
        const float mean = s * (1.0f / 1024.0f); float var = ss * (1.0f / 1024.0f) - mean * mean; var = var < 0.f ? 0.f : var;
        if (lane == 0) { st[2 * row] = mean; st[2 * row + 1] = 1.0f / sqrtf(var + EPS); }
    }
    __syncthreads();
    const int tb = wid & 3, ch = wid >> 2;
#pragma unroll 1
    for (int gi = 0; gi < 4; ++gi) {
        const int g = half * 4 + gi;
        { const int s = tid >> 2, c0 = (tid & 3) * 32;
          const bf16* vp = UV + (row0 + s) * 2048 + 1024 + g * 128 + c0;
          const float mean = st[2 * s], rstd = st[2 * s + 1];
#pragma unroll
          for (int q = 0; q < 4; ++q) { const u32x4 a = *(const u32x4*)(vp + 8 * q);
#pragma unroll
              for (int e = 0; e < 4; ++e) { const int c = c0 + 8 * q + 2 * e;
                  const float x0 = __builtin_bit_cast(float, a[e] << 16), x1 = __builtin_bit_cast(float, a[e] & 0xffff0000u);
                  const float n0 = (x0 - mean) * rstd * lng[g * 128 + c] + lnb[g * 128 + c], n1 = (x1 - mean) * rstd * lng[g * 128 + c + 1] + lnb[g * 128 + c + 1];
                  const unsigned w = pk2(n0, n1);
                  *(LAS unsigned short*)(vt + c * 272 + s * 2) = (unsigned short)(w & 0xffffu); *(LAS unsigned short*)(vt + (c + 1) * 272 + s * 2) = (unsigned short)(w >> 16); } } }
        __syncthreads();
        f32x16 acc[2]; acc[0] = f32x16{}; acc[1] = f32x16{};
        const bf16* wp = wsb + (size_t)(g * 128 + 32 * tb + r32) * 128 + 8 * hi;
        const int nks = 2 * (tb + 1);
        for (int ks = 0; ks < nks; ++ks) {
            const bf16x8 a = *(const bf16x8*)(wp + 16 * ks);
#pragma unroll
            for (int cb = 0; cb < 2; ++cb) { const bf16x8 bfr = *(const LAS bf16x8*)(vt + (64 * ch + 32 * cb + r32) * 272 + (16 * ks + 8 * hi) * 2);
                acc[cb] = __builtin_amdgcn_mfma_f32_32x32x16_bf16(a, bfr, acc[cb], 0, 0, 0); }
        }
#pragma unroll
        for (int cb = 0; cb < 2; ++cb)
#pragma unroll
            for (int r = 0; r < 16; ++r) { const int t = 32 * tb + (r & 3) + 8 * (r >> 2) + 4 * hi; const int col = g * 128 + 64 * ch + 32 * cb + r32;
                const float u = bf2f(UV[(row0 + t) * 2048 + col]); const float y = u * (acc[cb][r] + bs[g * 128 + t]);
                Yb[(row0 + t) * 1024 + col] = (bf16)(pk2(y, y) & 0xffffu); }
        __syncthreads();
    }
}

__global__ void __launch_bounds__(512, 2) mk_fwd(Params P) {
    extern __shared__ __attribute__((aligned(16))) unsigned char lds_raw[];
    LAS unsigned char* lds = (LAS unsigned char*)lds_raw;
    cg::grid_group grid = cg::this_grid();
    const int G = gridDim.x, bx = blockIdx.x;
    const int ngw = G * 8;
    unsigned char* ws = P.ws;
    bf16* Hb = (bf16*)(ws + WS_H);
    bf16* BIG = (bf16*)(ws + WS_BIG);
    bf16* Qb = BIG; bf16* Kb = BIG + (size_t)M * D; bf16* Vb = BIG + 2 * (size_t)M * D;
    float* Y = (float*)(ws + WS_Y);
    float* X = P.out;
    const float* norm_g = P.in[1];
    const int lo = P.ph_lo, hi_ph = P.ph_hi, coop = P.coop;
    int ph = 0;
#define PH_BEGIN if (ph >= lo && ph < hi_ph) { const int tid = otid(), lane = tid & 63, wid = __builtin_amdgcn_readfirstlane(tid >> 6), gw = bx * 8 + wid; (void)lane; (void)gw;
#define PH_END   if (coop && ph + 1 < hi_ph) grid.sync(); } ++ph;

    PH_BEGIN
    {
        LAS float* scr = (LAS float*)(lds + wid * 16640);
        constexpr int NIT = 4 * (2 * 1408 + 2 * 704) + 2 * (768 + 256) + (512 + 256) + (768 + 256);
        for (int it = gw; it < NIT; it += ngw) {
            int r = it;
            for (int mi = 0; mi < 24; ++mi) { const MatDesc md = get_mat(P, mi); const int cnt = (md.K >> 6) * (md.N >> 6);
                if (r < cnt) { transpose_item(md.W, md.K, md.N, md.WT, md.swiglu, scr, r, lane); break; } r -= cnt; }
        }
        { bf16* wsb = (bf16*)(ws + WS_WB + 6 * MiB); const float* w = P.in[12];
          for (int i = bx * 512 + tid; i < 8 * 128 * 128; i += G * 512) { const int t = (i >> 7) & 127, s = i & 127; const float v = (s <= t) ? w[i] : 0.f; wsb[i] = (bf16)(pk2(v, v) & 0xffffu); } }
        norm_phase(P.in[0], nullptr, 0.f, nullptr, norm_g, X, Hb, gw, ngw, lane);
    }
    PH_END

#pragma unroll 1
    for (int li = 0; li < NLAYER; ++li) {
        const float* g6 = norm_g + (size_t)li * 6 * D;
        const int kind = li % 3, jj = li / 3;
        unsigned char* wl = ws + WS_W + (size_t)li * 33 * MiB;
#pragma unroll 1
        for (int ff = 0; ff < 2; ++ff) {
            if (ff == 1) {
                PH_BEGIN
                if (kind == 1) {
                    pg8::Gemm g{Hb, (const bf16*)(ws + WS_WB), M, 2 * D, D}; pg8::StaticOrder So; So.init(M, 2 * D, G, bx);
                    pg8::EpiBf16<1> E{BIG, 2 * D, nullptr, 0, 0, 1.f};
                    pg8::gemm_phase<pg8::EpiBf16<1>, pg8::StaticOrder, true, true>(lds, g, So, E);
                } else {
                    const bf16* wq = (kind == 0) ? (const bf16*)(ws + WS_WA + (size_t)jj * 8 * MiB) : (const bf16*)(ws + WS_WC);
                    pg8::Gemm g{Hb, wq, M, 3 * D, D}; pg8::StaticOrder So; So.init(M, 3 * D, G, bx);
                    pg8::EpiBf16<0> E{Qb, D, nullptr, D, (size_t)M * D, 0.125f * LOG2E};
                    pg8::gemm_phase<pg8::EpiBf16<0>, pg8::StaticOrder, true, true>(lds, g, So, E);
                }
                PH_END
                PH_BEGIN
                if (kind == 0) {
                    const float* relb = P.in[7] + (size_t)jj * 16 * 257;
                    for (int u = bx; u < 1024; u += G) att::unit_a(lds, Qb, Kb, Vb, Qb, relb, u >> 9, (u >> 5) & 15, u & 31);
                } else if (kind == 1) {
                    for (int u = bx; u < 256; u += G) spatial_unit(lds, BIG, BIG + 2 * (size_t)M * D, P.in[10], P.in[11], (const bf16*)(ws + WS_WB + 6 * MiB), P.in[13], u);
                } else {
                    const float* lam = P.in[16];
                    const float sa = wave_sum(lam[lane] * lam[64 + lane]), sb = wave_sum(lam[128 + lane] * lam[192 + lane]);
                    const float lam_full = __expf(sa) - __expf(sb) + P.lam_init;
                    for (int u = bx; u < 512; u += G) { const int v = u & 255, bh = v >> 4, s = v & 15; att::unit_c(lds, Qb, Kb, Vb, Qb, Y, lam_full, P.in[17], P.lam_init, bh >> 3, bh & 7, (u < 256) ? s : 31 - s); }
                }
                PH_END
                PH_BEGIN
                {
                    const bf16* wo = (kind == 0) ? (const bf16*)(ws + WS_WA + (size_t)jj * 8 * MiB + 6 * MiB) : (kind == 1) ? (const bf16*)(ws + WS_WB + 4 * MiB) : (const bf16*)(ws + WS_WC + 6 * MiB);
                    const bf16* a = (kind == 1) ? BIG + 2 * (size_t)M * D : Qb;
                    pg8::Gemm g{a, wo, M, D, D}; pg8::StaticOrder So; So.init(M, D, G, bx);
                    pg8::EpiF32 E{Y, D};
                    pg8::gemm_phase<pg8::EpiF32, pg8::StaticOrder, false, true>(lds, g, So, E);
                }
                PH_END
                PH_BEGIN
                norm_phase(X, Y, 1.0f, g6 + 3 * D, g6 + 4 * D, X, Hb, gw, ngw, lane);
                PH_END
            }
            PH_BEGIN
            {
                const bf16* win = (const bf16*)(wl + (ff ? 16 * MiB + MiB / 2 : 0));
                pg8::Gemm g{Hb, win, M, 2 * DFF, D}; pg8::StaticOrder So; So.init(M, 2 * DFF, G, bx);
                pg8::EpiSwiGLU E{BIG, DFF};
                pg8::gemm_phase<pg8::EpiSwiGLU, pg8::StaticOrder, true, true>(lds, g, So, E);
            }
            PH_END
            PH_BEGIN
            {
                const bf16* wout = (const bf16*)(wl + (ff ? 27 * MiB + MiB / 2 : 11 * MiB));
                pg8::Gemm g{BIG, wout, M, D, DFF}; pg8::StaticOrder So; So.init(M, D, G, bx);
                pg8::EpiF32 E{Y, D};
                pg8::gemm_phase<pg8::EpiF32, pg8::StaticOrder, false, true>(lds, g, So, E);
            }
            PH_END
            PH_BEGIN
            {
                const float* gpost = g6 + (ff ? 5 : 1) * D;
                const float* gpre = ff ? (g6 + 6 * D) : (g6 + 2 * D);
                bf16* hout = (ff && li == NLAYER - 1) ? nullptr : Hb;
                norm_phase(X, Y, 0.5f, gpost, gpre, X, hout, gw, ngw, lane);
            }
            PH_END
        }
    }
#undef PH_BEGIN
#undef PH_END
}

constexpr int N_PHASES = 1 + NLAYER * 10;
#ifndef MK_MULTI
#define MK_MULTI 0
#endif

extern "C" void kernel_launch(void* const* d_in, const int* in_sizes, int n_in, void* d_out, int out_size, void* d_ws, size_t ws_size, hipStream_t stream) {
    static int grid = 0;
    if (grid == 0) {
        if (n_in != 19 || out_size != M * D || ws_size < WS_END) { fprintf(stderr, "kernel_launch: unexpected shapes n_in %d out %d ws %zu (need %zu)\n", n_in, out_size, ws_size, (size_t)WS_END); grid = -1; return; }
        int dev = 0, cus = 0, per_cu = 0;
        (void)hipGetDevice(&dev);
        (void)hipDeviceGetAttribute(&cus, hipDeviceAttributeMultiprocessorCount, dev);
        (void)hipFuncSetAttribute((const void*)mk_fwd, hipFuncAttributeMaxDynamicSharedMemorySize, LDS_BYTES);
        if (hipOccupancyMaxActiveBlocksPerMultiprocessor(&per_cu, (const void*)mk_fwd, 512, LDS_BYTES) != hipSuccess || per_cu < 1) per_cu = 1;
        (void)hipGetLastError();
        if (cus <= 0) cus = 256;
        grid = cus * 1;
    }
    if (grid < 0) return;
    Params p{};
    for (int i = 0; i < 19; ++i) p.in[i] = (const float*)d_in[i];
    p.out = (float*)d_out; p.ws = (unsigned char*)d_ws;
    p.lam_init = (float)(0.8 - 0.6 * exp(-0.3 * 2.0));
#if MK_MULTI
    for (int ph = 0; ph < N_PHASES; ++ph) {
        p.ph_lo = ph; p.ph_hi = ph + 1; p.coop = 0;
        hipLaunchKernelGGL(mk_fwd, dim3(grid), dim3(512), LDS_BYTES, stream, p);
    }
#else
    p.ph_lo = 0; p.ph_hi = N_PHASES; p.coop = 1;
    void* args[] = {&p};
    hipError_t e = hipLaunchCooperativeKernel((const void*)mk_fwd, dim3(grid), dim3(512), args, LDS_BYTES, stream);
    if (e != hipSuccess) fprintf(stderr, "cooperative launch failed: %s (grid %d)\n", hipGetErrorString(e), grid);
#endif
}
```

```cpp
#include <hip/hip_runtime.h>
#include <hip/hip_cooperative_groups.h>
#include <cstdio>
#include <cstdint>
#include <cmath>
namespace cg = cooperative_groups;
namespace pg8 {
#define PG8_LAS __attribute__((address_space(3)))
typedef unsigned short bf16_t;
typedef short bf16x8 __attribute__((ext_vector_type(8)));
typedef float f32x4 __attribute__((ext_vector_type(4)));
typedef unsigned u32x4 __attribute__((ext_vector_type(4)));
constexpr int BM = 256, BK = 64, HALF = 128, HTB = HALF * BK * 2  , STAGE_BYTES = 8 * HTB, NXCD = 8, WGM = 8;

__host__ __device__ __forceinline__ int lds_byte(int r, int c) { const int st = (r >> 4) * 2 + (c >> 5), rr = r & 15, cc = c & 31, ob = rr * 64 + cc * 2; return st * 1024 + (ob ^ (((ob >> 9) & 1) << 5)); }
__host__ __device__ __forceinline__ void stage_rc(int b, int& R, int& C) { const int st = b / 1024, sb = b % 1024, swz = sb ^ (((sb >> 9) & 1) << 5); R = (st >> 1) * 16 + swz / 64; C = (st & 1) * 32 + (swz % 64) / 2; }
__host__ __device__ __forceinline__ int perm32(int rho) { const int n = rho >> 4, i = rho & 15; return 8 * (i >> 2) + 4 * n + (i & 3); }

struct Unit { int pm, pn; };
struct Gemm { const bf16_t* A; const bf16_t* Bt; int M, N, K; };

struct StaticOrder {
    int nM, nN, nwg, G, c;
    __host__ __device__ void init(int M, int N, int G_, int c_) { nM = M / BM; nN = N / BM; nwg = nM * nN; G = G_; c = c_; }
    __host__ __device__ bool next(int i, Unit& u) const {
        const long L = (long)i * G + c; if (L >= nwg) return false;
        int wgid = (int)L; { const int q = nwg / NXCD, r = nwg % NXCD, xcd = wgid % NXCD, off = wgid / NXCD; wgid = (xcd < r ? xcd * (q + 1) : r * (q + 1) + (xcd - r) * q) + off; }
        const int nig = WGM * nN, gid = wgid / nig, fm = gid * WGM, gsz = (nM - fm) < WGM ? (nM - fm) : WGM;
        u.pm = fm + ((wgid % nig) % gsz); u.pn = (wgid % nig) / gsz; return true;
    }
    __device__ __forceinline__ void a_ready(const Unit&) const {}
    __device__ __forceinline__ void done(const Unit&) const {}
};

__device__ __forceinline__ unsigned cvt_pk_bf16(float lo, float hi) { unsigned r; asm volatile("v_cvt_pk_bf16_f32 %0, %1, %2" : "=v"(r) : "v"(lo), "v"(hi)); return r; }
typedef float f32x2 __attribute__((ext_vector_type(2)));
__device__ __forceinline__ f32x2 gelu_pk(f32x2 v) {
    const f32x2 av = __builtin_elementwise_abs(v), d = av * 0.2316418882f + 1.0f;
    f32x2 t; t.x = __builtin_amdgcn_rcpf(d.x); t.y = __builtin_amdgcn_rcpf(d.y);
    f32x2 q = t * 0.5307027145f + (-0.7265760135f); q = q * t + 0.7107068705f; q = q * t + (-0.142248368f); q = q * t + 0.127414796f; q = q * t;
    const f32x2 s = (v * v) * (-0.72134752044f);
    f32x2 e; e.x = __builtin_amdgcn_exp2f(s.x); e.y = __builtin_amdgcn_exp2f(s.y);
    const f32x2 m = v * (q * e), r = v - m;
    f32x2 o; o.x = v.x < 0.f ? m.x : r.x; o.y = v.y < 0.f ? m.y : r.y; return o;
}

template <int ACT  > struct EpiBf16 {
    static constexpr bool PERM = true, AFTER_DRAIN = false; static_assert(ACT == 0 || ACT == 1, "EpiBf16: ACT is 0 (none) or 1 (gelu_pk)");
    bf16_t* O; int ldc; const float* bias; int split_cols; size_t split_stride; float scale0;
    __device__ __forceinline__ void operator()(const f32x4 (&acc)[2][2][4][2], const Unit& u, int wr, int wc, int fr, int fq) const {
        const int row0 = u.pm * BM + wr * 64 + fr; int colt = u.pn * BM; bf16_t* base = O;
        float sc = 1.f; if (split_cols) { const int t = colt / split_cols; base += (size_t)t * split_stride; colt -= t * split_cols; if (t == 0) sc = scale0; }
        const int col0 = colt + wc * 32 + 8 * fq, bcol0 = u.pn * BM + wc * 32 + 8 * fq;
        f32x4 bv[2][2];
#pragma unroll
        for (int bj = 0; bj < 2; ++bj)
#pragma unroll
            for (int n = 0; n < 2; ++n) bv[bj][n] = bias ? *(const f32x4*)(bias + bcol0 + bj * HALF + 4 * n) : (f32x4){0.f, 0.f, 0.f, 0.f};
#pragma unroll
        for (int ai = 0; ai < 2; ++ai)
#pragma unroll
            for (int m = 0; m < 4; ++m) { bf16_t* rowp = base + (size_t)(row0 + ai * HALF + m * 16) * ldc + col0;
#pragma unroll
                for (int bj = 0; bj < 2; ++bj) { f32x4 v0 = acc[ai][bj][m][0] + bv[bj][0], v1 = acc[ai][bj][m][1] + bv[bj][1];
                    if (ACT == 1) { f32x2 a = gelu_pk((f32x2){v0[0], v0[1]}), b = gelu_pk((f32x2){v0[2], v0[3]}), c = gelu_pk((f32x2){v1[0], v1[1]}), d = gelu_pk((f32x2){v1[2], v1[3]});
                        v0 = (f32x4){a.x, a.y, b.x, b.y}; v1 = (f32x4){c.x, c.y, d.x, d.y}; }
                    v0 = v0 * sc; v1 = v1 * sc; u32x4 w; w.x = cvt_pk_bf16(v0[0], v0[1]); w.y = cvt_pk_bf16(v0[2], v0[3]); w.z = cvt_pk_bf16(v1[0], v1[1]); w.w = cvt_pk_bf16(v1[2], v1[3]);
                    *(u32x4*)(rowp + bj * HALF) = w; } }
    }
};
struct EpiSwiGLU {
    static constexpr bool PERM = true, AFTER_DRAIN = false;
    bf16_t* O; int ldc;
    __device__ __forceinline__ void operator()(const f32x4 (&acc)[2][2][4][2], const Unit& u, int wr, int wc, int fr, int fq) const {
        const int row0 = u.pm * BM + wr * 64 + fr, col0 = u.pn * HALF + wc * 32 + 8 * fq;
#pragma unroll
        for (int ai = 0; ai < 2; ++ai)
#pragma unroll
            for (int m = 0; m < 4; ++m) {
                bf16_t* rowp = O + (size_t)(row0 + ai * HALF + m * 16) * ldc + col0;
                float v[8];
#pragma unroll
                for (int n = 0; n < 2; ++n)
#pragma unroll
                    for (int e = 0; e < 4; ++e) {
                        const float g = acc[ai][0][m][n][e], up = acc[ai][1][m][n][e];
                        const float sg = g * __builtin_amdgcn_rcpf(1.0f + __builtin_amdgcn_exp2f(-1.4426950408889634f * g));
                        v[n * 4 + e] = sg * up;
                    }
                u32x4 w; w.x = cvt_pk_bf16(v[0], v[1]); w.y = cvt_pk_bf16(v[2], v[3]); w.z = cvt_pk_bf16(v[4], v[5]); w.w = cvt_pk_bf16(v[6], v[7]);
                *(u32x4*)rowp = w;
            }
    }
};
struct EpiF32 {
    static constexpr bool PERM = false, AFTER_DRAIN = false;
    float* O; int ldc;
    __device__ __forceinline__ void operator()(const f32x4 (&acc)[2][2][4][2], const Unit& u, int wr, int wc, int fr, int fq) const {
        const int row0 = u.pm * BM + wr * 64 + fr, col0 = u.pn * BM + wc * 32 + 4 * fq;
#pragma unroll
        for (int ai = 0; ai < 2; ++ai)
#pragma unroll
            for (int m = 0; m < 4; ++m) {
                float* rowp = O + (size_t)(row0 + ai * HALF + m * 16) * ldc + col0;
#pragma unroll
                for (int bj = 0; bj < 2; ++bj)
#pragma unroll
                    for (int n = 0; n < 2; ++n) *(f32x4*)(rowp + bj * HALF + n * 16) = acc[ai][bj][m][n];
            }
    }
};
template <class Epi, class Sched, bool ALIGN_EPI = false, bool SP2 = false>
__device__ __forceinline__ void gemm_phase(PG8_LAS unsigned char* lds, const Gemm g, const Sched& S, const Epi& E) {
    int tid_o = threadIdx.x; asm volatile("" : "+v"(tid_o)); const int tid = tid_o, wid = __builtin_amdgcn_readfirstlane(tid >> 6), lane = tid & 63, wr = wid >> 2, wc = wid & 3, fr = lane & 15, fq = lane >> 4;
    const int K = g.K, nt = K / BK;
    unsigned voffA[2], voffB[2];
#pragma unroll
    for (int i = 0; i < 2; ++i) { int R, C; stage_rc(tid * 16 + i * 8192, R, C); const int Rb = Epi::PERM ? ((R & ~31) + perm32(R & 31)) : R;
        voffA[i] = (unsigned)(R * K + C) * 2u; voffB[i] = (unsigned)(Rb * K + C) * 2u; }
    const size_t kstep = (size_t)(BK * 2);
    const size_t hstep = (size_t)HALF * K * 2;
    const size_t tstep = 2 * hstep;
    const unsigned ldsw = (unsigned)wid * 1024u;
    const int aoff = lds_byte(wr * 64 + fr, fq * 8), boff = lds_byte(wc * 32 + fr, fq * 8);
#define PG8_SA(b, h) (((b) * 2 + (h)) * HTB)
#define PG8_SB(b, h) ((4 + (b) * 2 + (h)) * HTB)
#define PG8_STAGE(bufoff, gbase, voff) do { _Pragma("unroll") for (int _i = 0; _i < 2; ++_i) \
        __builtin_amdgcn_global_load_lds((const unsigned*)((const char*)(gbase) + (voff)[_i]), (PG8_LAS unsigned*)(lds + (bufoff) + ldsw + _i * 8192), 16, 0, 0); } while (0)
#define PG8_LDA(dst, b, h) do { _Pragma("unroll") for (int m = 0; m < 4; ++m) _Pragma("unroll") for (int k = 0; k < 2; ++k) dst[m][k] = *(const PG8_LAS bf16x8*)(lds + PG8_SA(b, h) + aoff + m * 2048 + k * 1024); } while (0)
#define PG8_LDB(dst, b, h) do { _Pragma("unroll") for (int n = 0; n < 2; ++n) _Pragma("unroll") for (int k = 0; k < 2; ++k) dst[n][k] = *(const PG8_LAS bf16x8*)(lds + PG8_SB(b, h) + boff + n * 2048 + k * 1024); } while (0)
#define PG8_MMA(ai, bj, At, Bt) do { __builtin_amdgcn_s_setprio(1); _Pragma("unroll") for (int m = 0; m < 4; ++m) _Pragma("unroll") for (int n = 0; n < 2; ++n) _Pragma("unroll") for (int k = 0; k < 2; ++k) \
        acc[ai][bj][m][n] = __builtin_amdgcn_mfma_f32_16x16x32_bf16(Bt[n][k], At[m][k], acc[ai][bj][m][n], 0, 0, 0); __builtin_amdgcn_s_setprio(0); } while (0)
#define PG8_WAIT_V(n) asm volatile("s_waitcnt vmcnt(" #n ")" ::: "memory")
#define PG8_WAIT_L(n) asm volatile("s_waitcnt lgkmcnt(" #n ")" ::: "memory")
#define PG8_BAR __builtin_amdgcn_s_barrier()
#define PG8_SCHED __builtin_amdgcn_sched_barrier(0)
    Unit cur, nxt; int ui = 0;
    if (!S.next(0, cur)) return;
    f32x4 acc[2][2][4][2];
#pragma unroll
    for (int a = 0; a < 2; ++a)
#pragma unroll
        for (int b = 0; b < 2; ++b)
#pragma unroll
            for (int m = 0; m < 4; ++m)
#pragma unroll
                for (int n = 0; n < 2; ++n) acc[a][b][m][n] = (f32x4){0.f, 0.f, 0.f, 0.f};
    bf16x8 At[4][2], B0[2][2], B1[2][2];
    const char* cA = (const char*)g.A + (size_t)cur.pm * tstep; const char* cB = (const char*)g.Bt + (size_t)cur.pn * tstep;
    S.a_ready(cur);
    if constexpr (SP2) {
        PG8_STAGE(PG8_SB(0, 0), cB, voffB); PG8_STAGE(PG8_SB(0, 1), cB + hstep, voffB); PG8_STAGE(PG8_SA(0, 0), cA, voffA); PG8_STAGE(PG8_SA(0, 1), cA + hstep, voffA);
        if (wr == 1) PG8_BAR;
        PG8_WAIT_V(2); PG8_BAR;
        PG8_STAGE(PG8_SB(1, 0), cB + kstep, voffB); PG8_STAGE(PG8_SA(1, 0), cA + kstep, voffA); PG8_STAGE(PG8_SB(1, 1), cB + hstep + kstep, voffB);
        PG8_WAIT_V(6); PG8_BAR;
    } else {
        PG8_STAGE(PG8_SB(0, 0), cB, voffB); PG8_STAGE(PG8_SA(0, 0), cA, voffA); PG8_STAGE(PG8_SB(0, 1), cB + hstep, voffB); PG8_STAGE(PG8_SA(0, 1), cA + hstep, voffA);
        if (wr == 1) PG8_BAR;
        PG8_WAIT_V(4); PG8_BAR;
        PG8_STAGE(PG8_SB(1, 0), cB + kstep, voffB); PG8_STAGE(PG8_SA(1, 0), cA + kstep, voffA); PG8_STAGE(PG8_SB(1, 1), cB + hstep + kstep, voffB);
        PG8_WAIT_V(6); PG8_BAR;
    }
    for (;;) {
        const bool has_next = S.next(ui + 1, nxt);
        const char* nA = has_next ? (const char*)g.A + (size_t)nxt.pm * tstep : cA; const char* nB = has_next ? (const char*)g.Bt + (size_t)nxt.pn * tstep : cB;
        for (int t = 0; t < nt; t += 2) {
            const bool last = (t == nt - 2);
            const char* a1 = cA + (size_t)(t + 1) * kstep;
            const char* a2 = last ? nA : cA + (size_t)(t + 2) * kstep; const char* b2 = last ? nB : cB + (size_t)(t + 2) * kstep;
            const char* a3 = a2 + kstep; const char* b3 = b2 + kstep;
            if (last && has_next) S.a_ready(nxt);
            if constexpr (SP2) {
            PG8_LDB(B0, 0, 0); PG8_LDB(B1, 0, 1); PG8_SCHED; PG8_LDA(At, 0, 0); PG8_STAGE(PG8_SA(1, 1), a1 + hstep, voffA);
            PG8_WAIT_V(8); PG8_WAIT_L(0); PG8_BAR; PG8_MMA(0, 0, At, B0); PG8_MMA(0, 1, At, B1); PG8_BAR; PG8_SCHED;
            PG8_LDA(At, 0, 1); PG8_STAGE(PG8_SB(0, 0), b2, voffB); PG8_STAGE(PG8_SB(0, 1), b2 + hstep, voffB); PG8_STAGE(PG8_SA(0, 0), a2, voffA);
            PG8_WAIT_V(8); PG8_WAIT_L(0); PG8_BAR; PG8_MMA(1, 0, At, B0); PG8_MMA(1, 1, At, B1); PG8_BAR; PG8_SCHED;
            PG8_LDB(B0, 1, 0); PG8_LDB(B1, 1, 1); PG8_SCHED; PG8_LDA(At, 1, 0); PG8_STAGE(PG8_SA(0, 1), a2 + hstep, voffA);
            PG8_WAIT_V(8); PG8_WAIT_L(0); PG8_BAR; PG8_MMA(0, 0, At, B0); PG8_MMA(0, 1, At, B1); PG8_BAR; PG8_SCHED;
            PG8_LDA(At, 1, 1); PG8_STAGE(PG8_SB(1, 0), b3, voffB); PG8_STAGE(PG8_SB(1, 1), b3 + hstep, voffB); PG8_STAGE(PG8_SA(1, 0), a3, voffA);
            PG8_WAIT_V(8); PG8_WAIT_L(0); PG8_BAR; PG8_MMA(1, 0, At, B0); PG8_MMA(1, 1, At, B1); PG8_BAR; PG8_SCHED;
            } else {
            PG8_LDB(B0, 0, 0); PG8_SCHED; PG8_LDA(At, 0, 0); PG8_STAGE(PG8_SA(1, 1), a1 + hstep, voffA);
            PG8_WAIT_L(8); PG8_BAR; PG8_WAIT_L(0); PG8_MMA(0, 0, At, B0); PG8_BAR; PG8_SCHED;
            PG8_LDB(B1, 0, 1); PG8_STAGE(PG8_SB(0, 0), b2, voffB);
            PG8_BAR; PG8_WAIT_L(0); PG8_MMA(0, 1, At, B1); PG8_BAR;
            PG8_LDA(At, 0, 1); PG8_STAGE(PG8_SA(0, 0), a2, voffA);
            PG8_BAR; PG8_WAIT_L(0); PG8_MMA(1, 0, At, B0); PG8_BAR; PG8_SCHED;
            PG8_STAGE(PG8_SB(0, 1), b2 + hstep, voffB);
            PG8_WAIT_V(6); PG8_BAR; PG8_MMA(1, 1, At, B1); PG8_BAR;
            PG8_LDB(B0, 1, 0); PG8_SCHED; PG8_LDA(At, 1, 0); PG8_STAGE(PG8_SA(0, 1), a2 + hstep, voffA);
            PG8_WAIT_L(8); PG8_BAR; PG8_WAIT_L(0); PG8_MMA(0, 0, At, B0); PG8_BAR; PG8_SCHED;
            PG8_LDB(B1, 1, 1); PG8_STAGE(PG8_SB(1, 0), b3, voffB);
            PG8_BAR; PG8_WAIT_L(0); PG8_MMA(0, 1, At, B1); PG8_BAR;
            PG8_LDA(At, 1, 1); PG8_STAGE(PG8_SA(1, 0), a3, voffA);
            PG8_BAR; PG8_WAIT_L(0); PG8_MMA(1, 0, At, B0); PG8_BAR; PG8_SCHED;
            PG8_STAGE(PG8_SB(1, 1), b3 + hstep, voffB);
            PG8_WAIT_V(6); PG8_BAR; PG8_MMA(1, 1, At, B1); PG8_BAR;
            }
        }
        if constexpr (ALIGN_EPI) { if (wr == 0) PG8_BAR; }
        if constexpr (!Epi::AFTER_DRAIN) { E(acc, cur, wr, wc, fr, fq); S.done(cur); }
        if (!has_next) break;
#pragma unroll
        for (int a = 0; a < 2; ++a)
#pragma unroll
            for (int b = 0; b < 2; ++b)
#pragma unroll
                for (int m = 0; m < 4; ++m)
#pragma unroll
                    for (int n = 0; n < 2; ++n) acc[a][b][m][n] = (f32x4){0.f, 0.f, 0.f, 0.f};
        cur = nxt; cA = nA; cB = nB; ++ui;
        if constexpr (ALIGN_EPI) { if (wr == 1) PG8_BAR; }
    }
    PG8_WAIT_V(0);
    if constexpr (!ALIGN_EPI) { if (wr == 0) PG8_BAR; }
    PG8_BAR;
    if constexpr (Epi::AFTER_DRAIN) { E.fused(acc, cur, wr, wc, fr, fq, lds, wid, lane); S.done(cur); }
#undef PG8_SA
#undef PG8_SB
#undef PG8_STAGE
#undef PG8_LDA
#undef PG8_LDB
#undef PG8_MMA
#undef PG8_WAIT_V
#undef PG8_WAIT_L
#undef PG8_BAR
#undef PG8_SCHED
}
}
#define LAS __attribute__((address_space(3)))
typedef unsigned short bf16;
typedef short bf16x8 __attribute__((ext_vector_type(8)));
typedef short s16x4 __attribute__((ext_vector_type(4)));
typedef float f32x4 __attribute__((ext_vector_type(4)));
typedef float f32x16 __attribute__((ext_vector_type(16)));
typedef unsigned u32x4 __attribute__((ext_vector_type(4)));
typedef unsigned u32x2 __attribute__((ext_vector_type(2)));

constexpr int M = 16384, D = 1024, S = 8192, DFF = 2816, NLAYER = 4;
constexpr float EPS = 1e-6f, LOG2E = 1.4426950408889634f;
constexpr size_t MiB = 1u << 20;
constexpr size_t WS_W = 1 * MiB;
constexpr size_t WS_WA = WS_W + 132 * MiB;
constexpr size_t WS_WB = WS_WA + 16 * MiB;
constexpr size_t WS_WC = WS_WB + 7 * MiB;
constexpr size_t WS_H = WS_WC + 8 * MiB;
constexpr size_t WS_BIG = WS_H + 32 * MiB;
constexpr size_t WS_Y = WS_BIG + 96 * MiB;
constexpr size_t WS_END = WS_Y + 64 * MiB;
constexpr int LDS_BYTES = 147456;
#ifndef MK_DUP
#define MK_DUP 0
#endif
#define DUPN(bit) ((MK_DUP & (bit)) ? 2 : 1)

struct Params {
    const float* in[19];
    float* out;
    unsigned char* ws;
    float lam_init;
    int ph_lo, ph_hi, coop;
};

__device__ __forceinline__ int otid() { int t = threadIdx.x; asm volatile("" : "+v"(t)); return t; }
__device__ __forceinline__ float bf2f(unsigned short v) { return __builtin_bit_cast(float, (unsigned)v << 16); }
__device__ __forceinline__ unsigned pk2(float lo, float hi) { return pg8::cvt_pk_bf16(lo, hi); }
__device__ __forceinline__ float wave_sum(float v) {
#pragma unroll
    for (int o = 1; o < 64; o <<= 1) v += __shfl_xor(v, o);
    return v;
}

#define XB_TMO      128
#define XB_XCNT(j)  (256  + 64 * (j))
#define XB_XSUB(j)  (1280 + 64 * (j))
#define XB_XGEN(j)  (2304 + 64 * (j))
#define XB_TOP      3328
#define XB_TOPGEN   3392
#define XCD_BAR_WORDS 3456
#define XB_SPIN_CAP (1u << 18)

__device__ __forceinline__ unsigned xb_ld(unsigned* p)              { return __hip_atomic_load(p, __ATOMIC_RELAXED, __HIP_MEMORY_SCOPE_AGENT); }
__device__ __forceinline__ unsigned xb_add(unsigned* p, unsigned v) { return __hip_atomic_fetch_add(p, v, __ATOMIC_RELAXED, __HIP_MEMORY_SCOPE_AGENT); }
__device__ __forceinline__ unsigned xb_xcc_id() { return (unsigned)__builtin_amdgcn_s_getreg((3 << 11) | 20) & 0xFu; }
#define XB_SPIN(cond, bar) do { unsigned _sp = 0; while (cond) { __builtin_amdgcn_s_sleep(1); \
    if ((++_sp & 255u) == 0u) { if (xb_ld(&(bar)[XB_TMO])) break; if (_sp > XB_SPIN_CAP) { atomicAdd(&(bar)[XB_TMO], 1u); break; } } } } while (0)

struct XcdBarrier {
    unsigned* bar; unsigned x;
    volatile LAS unsigned* st;
};

__device__ __forceinline__ XcdBarrier xcd_barrier_post(unsigned* bar, volatile LAS unsigned* st) {
    XcdBarrier b; b.bar = bar; b.x = xb_xcc_id(); b.st = st;
    if (threadIdx.x == 0) (void)xb_add(&bar[XB_XCNT(b.x)], 1u);
    return b;
}
__device__ __forceinline__ void xcd_barrier_complete(unsigned* bar, unsigned x, unsigned& nloc, unsigned& nx) {
    const unsigned G = gridDim.x * gridDim.y * gridDim.z;
    unsigned sum, cnt, mine, sp = 0u;
    for (;;) {
        sum = 0u; cnt = 0u; mine = 0u;
#pragma unroll
        for (unsigned j = 0; j < 16; ++j) { const unsigned c = xb_ld(&bar[XB_XCNT(j)]); sum += c; cnt += (c > 0u) ? 1u : 0u; mine = (j == x) ? c : mine; }
        if (sum == G) break;
        __builtin_amdgcn_s_sleep(1);
        if ((++sp & 255u) == 0u) { if (xb_ld(&bar[XB_TMO])) break; if (sp > XB_SPIN_CAP) { atomicAdd(&bar[XB_TMO], 1u); break; } }
    }
    nloc = mine > 0u ? mine : 1u; nx = cnt > 0u ? cnt : 1u;
}

__device__ __forceinline__ void xcd_barrier(const XcdBarrier& b) {
    asm volatile("s_waitcnt vmcnt(0)" ::: "memory");
    __syncthreads();
    if (threadIdx.x == 0) {
        unsigned* bar = b.bar;
        __builtin_amdgcn_s_waitcnt(0);
        unsigned nloc = b.st[0], nx = b.st[1];
        if (nloc == 0u) { xcd_barrier_complete(bar, b.x, nloc, nx); b.st[0] = nloc; b.st[1] = nx; }
        const unsigned old = xb_add(&bar[XB_XSUB(b.x)], 1u);
        const unsigned gen = old / nloc;
        if (old + 1u == (gen + 1u) * nloc) {
            __builtin_amdgcn_fence(__ATOMIC_RELEASE, "agent");
            asm volatile("s_waitcnt vmcnt(0)" ::: "memory");
            const unsigned og = xb_add(&bar[XB_TOP], 1u);
            const unsigned tg = og / nx;
            if (og + 1u == (tg + 1u) * nx) xb_add(&bar[XB_TOPGEN], 1u);
            else XB_SPIN(xb_ld(&bar[XB_TOPGEN]) == tg, bar);
            __builtin_amdgcn_fence(__ATOMIC_ACQUIRE, "agent");
            xb_add(&bar[XB_XGEN(b.x)], 1u);
            asm volatile("s_waitcnt vmcnt(0)" ::: "memory");
        } else {
            XB_SPIN(xb_ld(&bar[XB_XGEN(b.x)]) == gen, bar);
            __builtin_amdgcn_fence(__ATOMIC_ACQUIRE, "agent");
            asm volatile("s_waitcnt vmcnt(0)" ::: "memory");
        }
    }
    __syncthreads();
}

__device__ __forceinline__ void transpose_item(const float* __restrict__ W, int K, int N, bf16* __restrict__ WT, int swiglu, LAS float* scr, int item, int lane) {
    const int nblk = N / 64, kb = item / nblk, nb = item % nblk, k0 = 64 * kb, n0 = 64 * nb;
#pragma unroll 4
    for (int i = 0; i < 16; ++i) {
        const int kk = 4 * i + (lane >> 4);
        const f32x4 v = *(const f32x4*)(W + (size_t)(k0 + kk) * N + n0 + 4 * (lane & 15));
        LAS float* s = scr + kk * 65 + 4 * (lane & 15);
        s[0] = v.x; s[1] = v.y; s[2] = v.z; s[3] = v.w;
    }
    asm volatile("s_waitcnt lgkmcnt(0)" ::: "memory");
    const int c = lane & 7;
#pragma unroll
    for (int j = 0; j < 8; ++j) {
        const int n = (lane >> 3) + 8 * j;
        const LAS float* s = scr + (8 * c) * 65 + n;
        u32x4 o; o.x = pk2(s[0], s[65]); o.y = pk2(s[2 * 65], s[3 * 65]); o.z = pk2(s[4 * 65], s[5 * 65]); o.w = pk2(s[6 * 65], s[7 * 65]);
        const int nn = n0 + n;
        int row = nn;
        if (swiglu) { row = (nn < DFF) ? ((nn >> 7) * 256 + (nn & 127)) : ((((nn - DFF) >> 7) * 256) + 128 + ((nn - DFF) & 127)); }
        *(u32x4*)(WT + (size_t)row * K + k0 + 8 * c) = o;
    }
    asm volatile("s_waitcnt lgkmcnt(0)" ::: "memory");
}

struct MatDesc { const float* W; bf16* WT; int K, N, swiglu; };
__device__ __forceinline__ MatDesc get_mat(const Params& P, int mi) {
    MatDesc d; unsigned char* ws = P.ws;
    if (mi < 16) {
        const int L = mi >> 2, w = mi & 3;
        unsigned char* base = ws + WS_W + (size_t)L * 33 * MiB;
        if (w == 0)      { d.W = P.in[2] + (size_t)L * D * 2 * DFF; d.WT = (bf16*)base; d.K = D; d.N = 2 * DFF; d.swiglu = 1; }
        else if (w == 1) { d.W = P.in[3] + (size_t)L * DFF * D; d.WT = (bf16*)(base + 11 * MiB); d.K = DFF; d.N = D; d.swiglu = 0; }
        else if (w == 2) { d.W = P.in[4] + (size_t)L * D * 2 * DFF; d.WT = (bf16*)(base + 16 * MiB + MiB / 2); d.K = D; d.N = 2 * DFF; d.swiglu = 1; }
        else             { d.W = P.in[5] + (size_t)L * DFF * D; d.WT = (bf16*)(base + 27 * MiB + MiB / 2); d.K = DFF; d.N = D; d.swiglu = 0; }
    } else if (mi < 20) {
        const int j = (mi - 16) >> 1, w = (mi - 16) & 1;
        unsigned char* base = ws + WS_WA + (size_t)j * 8 * MiB;
        if (w == 0) { d.W = P.in[6] + (size_t)j * D * 3 * D; d.WT = (bf16*)base; d.K = D; d.N = 3 * D; d.swiglu = 0; }
        else        { d.W = P.in[8] + (size_t)j * D * D; d.WT = (bf16*)(base + 6 * MiB); d.K = D; d.N = D; d.swiglu = 0; }
    } else if (mi < 22) {
        if (mi == 20) { d.W = P.in[9]; d.WT = (bf16*)(ws + WS_WB); d.K = D; d.N = 2 * D; d.swiglu = 0; }
        else          { d.W = P.in[14]; d.WT = (bf16*)(ws + WS_WB + 4 * MiB); d.K = D; d.N = D; d.swiglu = 0; }
    } else {
        if (mi == 22) { d.W = P.in[15]; d.WT = (bf16*)(ws + WS_WC); d.K = D; d.N = 3 * D; d.swiglu = 0; }
        else          { d.W = P.in[18]; d.WT = (bf16*)(ws + WS_WC + 6 * MiB); d.K = D; d.N = D; d.swiglu = 0; }
    }
    return d;
}

__device__ __forceinline__ void norm_phase(const float* xin, const float* y, float coef, const float* gpost, const float* gpre, float* xout, bf16* h, int gw, int ngw, int lane) {
    for (int row = gw; row < M; row += ngw) {
        const f32x4* xr = (const f32x4*)(xin + (size_t)row * D) + lane;
        f32x4 v[4];
#pragma unroll
        for (int j = 0; j < 4; ++j) v[j] = xr[64 * j];
        if (y) {
            const f32x4* yr = (const f32x4*)(y + (size_t)row * D) + lane;
            f32x4 yv[4]; float ss = 0.f;
#pragma unroll
            for (int j = 0; j < 4; ++j) { yv[j] = yr[64 * j]; ss += (yv[j].x * yv[j].x + yv[j].y * yv[j].y) + (yv[j].z * yv[j].z + yv[j].w * yv[j].w); }
            const float rs = coef / sqrtf(wave_sum(ss) * (1.0f / D) + EPS);
#pragma unroll
            for (int j = 0; j < 4; ++j) { const f32x4 g = ((const f32x4*)gpost)[lane + 64 * j]; v[j] += yv[j] * rs * g; }
        }
        if (xout) {
            f32x4* xo = (f32x4*)(xout + (size_t)row * D) + lane;
#pragma unroll
            for (int j = 0; j < 4; ++j) xo[64 * j] = v[j];
        }
        if (h) {
            float ss = 0.f;
#pragma unroll
            for (int j = 0; j < 4; ++j) ss += (v[j].x * v[j].x + v[j].y * v[j].y) + (v[j].z * v[j].z + v[j].w * v[j].w);
            const float rs = 1.0f / sqrtf(wave_sum(ss) * (1.0f / D) + EPS);
            u32x2* ho = (u32x2*)(h + (size_t)row * D) + lane;
#pragma unroll
            for (int j = 0; j < 4; ++j) { const f32x4 g = ((const f32x4*)gpre)[lane + 64 * j]; const f32x4 o = v[j] * rs * g; u32x2 w; w.x = pk2(o.x, o.y); w.y = pk2(o.z, o.w); ho[64 * j] = w; }
        }
    }
}

namespace att {
constexpr int KP = 144;
template <int DV> struct L { static constexpr int VP = DV * 2 + 64, KB = 64 * KP, VB = 64 * VP, BUF = KB + VB; };
typedef short v4i16_t __attribute__((ext_vector_type(4)));
__device__ __forceinline__ s16x4 vtr(const LAS unsigned char* p) { return __builtin_bit_cast(s16x4, __builtin_amdgcn_ds_read_tr16_b64_v4i16((LAS v4i16_t*)p)); }
__device__ __forceinline__ bf16x8 pack8(const f32x16& p, int b) {
    u32x4 w; w.x = pk2(p[b], p[b + 1]); w.y = pk2(p[b + 2], p[b + 3]); w.z = pk2(p[b + 4], p[b + 5]); w.w = pk2(p[b + 6], p[b + 7]);
    return __builtin_bit_cast(bf16x8, w);
}
template <int DV, int MODE>
__device__ __forceinline__ void stream(LAS unsigned char* lds, const bf16* __restrict__ Kg, const bf16* __restrict__ Vg, int T0, int T1, int wlo, int whi,
                                       const bf16x8 (&qr)[4], int qw0, float slope2, const LAS float* tbl, f32x16 (&o)[DV / 32], float& m, float& l) {
    constexpr int VP = L<DV>::VP, KB = L<DV>::KB, BUF = L<DV>::BUF, NV = DV / 64, VCH = DV / 8;
    const int tid = otid(), lane = tid & 63, r32 = lane & 31, hi = lane >> 5;
    const int krow = tid >> 3, kch = tid & 7;
    u32x4 kreg; u32x4 vreg[NV];
#define ATT_GLOAD(t) do { kreg = *(const u32x4*)(Kg + (size_t)(64 * (t) + krow) * 1024 + kch * 8); \
        _Pragma("unroll") for (int i_ = 0; i_ < NV; ++i_) { const int idx_ = tid + 512 * i_; const int vr_ = idx_ / VCH, vc_ = idx_ % VCH; \
            vreg[i_] = *(const u32x4*)(Vg + (size_t)(64 * (t) + vr_) * 1024 + vc_ * 8); } } while (0)
#define ATT_LSTORE(buf) do { *(LAS u32x4*)(lds + (buf) * BUF + krow * KP + kch * 16) = kreg; \
        _Pragma("unroll") for (int i_ = 0; i_ < NV; ++i_) { const int idx_ = tid + 512 * i_; const int vr_ = idx_ / VCH, vc_ = idx_ % VCH; \
            *(LAS u32x4*)(lds + (buf) * BUF + KB + vr_ * VP + vc_ * 16) = vreg[i_]; } } while (0)
    ATT_GLOAD(T0); ATT_LSTORE(0); __syncthreads();
    const int g4 = lane >> 4, i16 = lane & 15;
    const int voff = (4 * (g4 >> 1) + (i16 >> 2)) * VP + (16 * (g4 & 1) + 4 * (i16 & 3)) * 2;
    for (int t = T0; t < T1; ++t) {
        const int cur = (t - T0) & 1; const bool more = (t + 1 < T1);
        if (more) ATT_GLOAD(t + 1);
        if (t >= wlo && t <= whi) {
            const LAS unsigned char* Kl = lds + cur * BUF; const LAS unsigned char* Vl = Kl + KB;
            f32x16 p0 = {}, p1 = {};
#pragma unroll
            for (int d0 = 0; d0 < 4; ++d0) {
                const bf16x8 b0 = *(const LAS bf16x8*)(Kl + r32 * KP + d0 * 32 + hi * 16);
                const bf16x8 b1 = *(const LAS bf16x8*)(Kl + (32 + r32) * KP + d0 * 32 + hi * 16);
                p0 = __builtin_amdgcn_mfma_f32_32x32x16_bf16(b0, qr[d0], p0, 0, 0, 0);
                p1 = __builtin_amdgcn_mfma_f32_32x32x16_bf16(b1, qr[d0], p1, 0, 0, 0);
            }
            if (MODE == 1) {
                const float dq = (float)(qw0 + r32 - 64 * t - 4 * hi);
#pragma unroll
                for (int r = 0; r < 16; ++r) { const float c = (float)((r & 3) + 8 * (r >> 2));
                    p0[r] = __builtin_fmaf(-slope2, __builtin_fabsf(dq - c), p0[r]); p1[r] = __builtin_fmaf(-slope2, __builtin_fabsf(dq - (c + 32.0f)), p1[r]); }
            } else {
                if (qw0 - (64 * t + 63) >= 128) { const float c = tbl[256];
#pragma unroll
                    for (int r = 0; r < 16; ++r) { p0[r] += c; p1[r] += c; }
                } else { const int dq = qw0 + r32 - 64 * t - 4 * hi + 128;
#pragma unroll
                    for (int r = 0; r < 16; ++r) { const int c = (r & 3) + 8 * (r >> 2);
                        int i0 = dq - c; i0 = i0 < 0 ? 0 : (i0 > 256 ? 256 : i0); int i1 = dq - c - 32; i1 = i1 < 0 ? 0 : (i1 > 256 ? 256 : i1);
                        p0[r] += tbl[i0]; p1[r] += tbl[i1]; }
                }
            }
            float mx = __builtin_fmaxf(p0[0], p1[0]);
#pragma unroll
            for (int r = 1; r < 16; ++r) mx = __builtin_fmaxf(mx, __builtin_fmaxf(p0[r], p1[r]));
            mx = __builtin_fmaxf(mx, __shfl_xor(mx, 32));
            if (__any(mx > m)) {
                const float mn = __builtin_fmaxf(m, mx); const float f = __builtin_amdgcn_exp2f(m - mn); m = mn; l *= f;
#pragma unroll
                for (int db = 0; db < DV / 32; ++db) o[db] *= f;
            }
            float ls = 0.f;
#pragma unroll
            for (int r = 0; r < 16; ++r) { p0[r] = __builtin_amdgcn_exp2f(p0[r] - m); p1[r] = __builtin_amdgcn_exp2f(p1[r] - m); ls += p0[r] + p1[r]; }
            l += ls;
            bf16x8 pa[4]; pa[0] = pack8(p0, 0); pa[1] = pack8(p0, 8); pa[2] = pack8(p1, 0); pa[3] = pack8(p1, 8);
            const LAS unsigned char* vb = Vl + voff;
#pragma unroll
            for (int db = 0; db < DV / 32; ++db)
#pragma unroll
                for (int s = 0; s < 4; ++s) {
                    const s16x4 lo = vtr(vb + (16 * s) * VP + db * 64), hh = vtr(vb + (16 * s + 8) * VP + db * 64);
                    const bf16x8 vf = (bf16x8){lo[0], lo[1], lo[2], lo[3], hh[0], hh[1], hh[2], hh[3]};
                    o[db] = __builtin_amdgcn_mfma_f32_32x32x16_bf16(vf, pa[s], o[db], 0, 0, 0);
                }
        }
        if (more) ATT_LSTORE(cur ^ 1);
        __syncthreads();
    }
#undef ATT_GLOAD
#undef ATT_LSTORE
}

__device__ __forceinline__ void unit_a(LAS unsigned char* lds, const bf16* Q, const bf16* K, const bf16* V, bf16* O, const float* relb, int b, int h, int qb) {
    const int tid = otid(), lane = tid & 63, r32 = lane & 31, hi = lane >> 5, wid = __builtin_amdgcn_readfirstlane(tid >> 6);
    LAS float* tbl = (LAS float*)(lds + 2 * L<64>::BUF);
    for (int i = tid; i < 257; i += 512) tbl[i] = relb[h * 257 + i] * LOG2E;
    const size_t rowbase = (size_t)b * S; const int qw0 = 256 * qb + 32 * wid, qpos = qw0 + r32;
    bf16x8 qr[4];
    const bf16* qp = Q + (rowbase + qpos) * 1024 + h * 64 + hi * 8;
#pragma unroll
    for (int d0 = 0; d0 < 4; ++d0) qr[d0] = *(const bf16x8*)(qp + d0 * 16);
    const int cw = qw0 >> 6; const int wlo = cw - 8 < 0 ? 0 : cw - 8, whi = cw;
    const int T0 = 4 * qb - 8 < 0 ? 0 : 4 * qb - 8, T1 = 4 * qb + 4;
    f32x16 o[2]; o[0] = f32x16{}; o[1] = f32x16{}; float m = -1e30f, l = 0.f;
    stream<64, 0>(lds, K + rowbase * 1024 + h * 64, V + rowbase * 1024 + h * 64, T0, T1, wlo, whi, qr, qw0, 0.f, tbl, o, m, l);
    l += __shfl_xor(l, 32); const float inv = 1.0f / l;
    bf16* op = O + (rowbase + qpos) * 1024 + h * 64 + 4 * hi;
#pragma unroll
    for (int db = 0; db < 2; ++db)
#pragma unroll
        for (int rr = 0; rr < 4; ++rr) { u32x2 w; w.x = pk2(o[db][4 * rr] * inv, o[db][4 * rr + 1] * inv); w.y = pk2(o[db][4 * rr + 2] * inv, o[db][4 * rr + 3] * inv);
            *(u32x2*)(op + 32 * db + 8 * rr) = w; }
}

__device__ __forceinline__ void unit_c(LAS unsigned char* lds, const bf16* Q, const bf16* K, const bf16* V, bf16* O, float* keepbuf, float lam_full, const float* subg, float lam_init, int b, int h, int qb) {
    const int tid = otid(), lane = tid & 63, r32 = lane & 31, hi = lane >> 5, wid = __builtin_amdgcn_readfirstlane(tid >> 6);
    const size_t rowbase = (size_t)b * S; const int qw0 = 256 * qb + 32 * wid, qpos = qw0 + r32;
    const int whi = qw0 >> 6, T1 = 4 * qb + 4;
    float* kp = keepbuf + (rowbase + qpos) * 1024 + h * 128 + 4 * hi;
    const float slope2 = __builtin_amdgcn_exp2f(-(float)(h + 1)) * LOG2E;
    f32x16 o[4];
#pragma unroll 1
    for (int mp = 0; mp < 2; ++mp) {
        bf16x8 qr[4];
        const bf16* qp = Q + (rowbase + qpos) * 1024 + h * 128 + mp * 64 + hi * 8;
#pragma unroll
        for (int d0 = 0; d0 < 4; ++d0) qr[d0] = *(const bf16x8*)(qp + d0 * 16);
#pragma unroll
        for (int db = 0; db < 4; ++db) o[db] = f32x16{};
        float m = -1e30f, l = 0.f;
        stream<128, 1>(lds, K + rowbase * 1024 + h * 128 + mp * 64, V + rowbase * 1024 + h * 128, 0, T1, 0, whi, qr, qw0, slope2, nullptr, o, m, l);
        l += __shfl_xor(l, 32); const float inv = 1.0f / l;
        if (mp == 0) {
#pragma unroll
            for (int db = 0; db < 4; ++db)
#pragma unroll
                for (int rr = 0; rr < 4; ++rr) *(f32x4*)(kp + 32 * db + 8 * rr) = (f32x4){o[db][4 * rr] * inv, o[db][4 * rr + 1] * inv, o[db][4 * rr + 2] * inv, o[db][4 * rr + 3] * inv};
        } else {
            const float c = lam_full * inv;
#pragma unroll
            for (int db = 0; db < 4; ++db)
#pragma unroll
                for (int rr = 0; rr < 4; ++rr) { const f32x4 k4 = *(const f32x4*)(kp + 32 * db + 8 * rr);
                    o[db][4 * rr] = k4.x - o[db][4 * rr] * c; o[db][4 * rr + 1] = k4.y - o[db][4 * rr + 1] * c; o[db][4 * rr + 2] = k4.z - o[db][4 * rr + 2] * c; o[db][4 * rr + 3] = k4.w - o[db][4 * rr + 3] * c; }
        }
    }
    float ss = 0.f;
#pragma unroll
    for (int db = 0; db < 4; ++db)
#pragma unroll
        for (int r = 0; r < 16; ++r) ss += o[db][r] * o[db][r];
    ss += __shfl_xor(ss, 32);
    const float rs = (1.0f - lam_init) / sqrtf(ss * (1.0f / 128.0f) + EPS);
    bf16* op = O + (rowbase + qpos) * 1024 + h * 128 + 4 * hi;
#pragma unroll
    for (int db = 0; db < 4; ++db)
#pragma unroll
        for (int rr = 0; rr < 4; ++rr) { const f32x4 g = *(const f32x4*)(subg + 32 * db + 8 * rr + 4 * hi);
            u32x2 w; w.x = pk2(o[db][4 * rr] * rs * g.x, o[db][4 * rr + 1] * rs * g.y); w.y = pk2(o[db][4 * rr + 2] * rs * g.z, o[db][4 * rr + 3] * rs * g.w);
            *(u32x2*)(op + 32 * db + 8 * rr) = w; }
}
}

__device__ __forceinline__ void spatial_unit(LAS unsigned char* lds, const bf16* UV, bf16* Yb, const float* lng, const float* lnb, const bf16* wsb, const float* bs, int unit) {
    const int tid = otid(), lane = tid & 63, r32 = lane & 31, hi = lane >> 5, wid = __builtin_amdgcn_readfirstlane(tid >> 6);
    const int chunk = unit >> 1, half = unit & 1; const size_t row0 = (size_t)chunk * 128;
    LAS float* st = (LAS float*)lds;
    LAS unsigned char* vt = lds + 1024;
    for (int rr = 0; rr < 16; ++rr) {
        const int row = 16 * wid + rr;
        const bf16* vp = UV + (row0 + row) * 2048 + 1024 + lane * 16;
        const u32x4 a = *(const u32x4*)vp, b2 = *(const u32x4*)(vp + 8);
        float s = 0.f, ss = 0.f;
#pragma unroll
        for (int e = 0; e < 4; ++e) { const float x0 = __builtin_bit_cast(float, a[e] << 16), x1 = __builtin_bit_cast(float, a[e] & 0xffff0000u), y0 = __builtin_bit_cast(float, b2[e] << 16), y1 = __builtin_bit_cast(float, b2[e] & 0xffff0000u);
            s += (x0 + x1) + (y0 + y1); ss += (x0 * x0 + x1 * x1) + (y0 * y0 + y1 * y1); }
        s = wave_sum(s); ss = wave_sum(ss);
        const float mean = s * (1.0f / 1024.0f); float var = ss * (1.0f / 1024.0f) - mean * mean; var = var < 0.f ? 0.f : var;
        if (lane == 0) { st[2 * row] = mean; st[2 * row + 1] = 1.0f / sqrtf(var + EPS); }
    }
    __syncthreads();
    const int tb = wid & 3, ch = wid >> 2;
#pragma unroll 1
    for (int gi = 0; gi < 4; ++gi) {
        const int g = half * 4 + gi;
        { const int s = tid >> 2, c0 = (tid & 3) * 32;
          const bf16* vp = UV + (row0 + s) * 2048 + 1024 + g * 128 + c0;
          const float mean = st[2 * s], rstd = st[2 * s + 1];
#pragma unroll
          for (int q = 0; q < 4; ++q) { const u32x4 a = *(const u32x4*)(vp + 8 * q);
#pragma unroll
              for (int e = 0; e < 4; ++e) { const int c = c0 + 8 * q + 2 * e;
                  const float x0 = __builtin_bit_cast(float, a[e] << 16), x1 = __builtin_bit_cast(float, a[e] & 0xffff0000u);
                  const float n0 = (x0 - mean) * rstd * lng[g * 128 + c] + lnb[g * 128 + c], n1 = (x1 - mean) * rstd * lng[g * 128 + c + 1] + lnb[g * 128 + c + 1];
                  const unsigned w = pk2(n0, n1);
                  *(LAS unsigned short*)(vt + c * 272 + s * 2) = (unsigned short)(w & 0xffffu); *(LAS unsigned short*)(vt + (c + 1) * 272 + s * 2) = (unsigned short)(w >> 16); } } }
        __syncthreads();
        f32x16 acc[2]; acc[0] = f32x16{}; acc[1] = f32x16{};
        const bf16* wp = wsb + (size_t)(g * 128 + 32 * tb + r32) * 128 + 8 * hi;
        const int nks = 2 * (tb + 1);
        for (int ks = 0; ks < nks; ++ks) {
            const bf16x8 a = *(const bf16x8*)(wp + 16 * ks);
#pragma unroll
            for (int cb = 0; cb < 2; ++cb) { const bf16x8 bfr = *(const LAS bf16x8*)(vt + (64 * ch + 32 * cb + r32) * 272 + (16 * ks + 8 * hi) * 2);
                acc[cb] = __builtin_amdgcn_mfma_f32_32x32x16_bf16(a, bfr, acc[cb], 0, 0, 0); }
        }
#pragma unroll
        for (int cb = 0; cb < 2; ++cb)
#pragma unroll
            for (int r = 0; r < 16; ++r) { const int t = 32 * tb + (r & 3) + 8 * (r >> 2) + 4 * hi; const int col = g * 128 + 64 * ch + 32 * cb + r32;
                const float u = bf2f(UV[(row0 + t) * 2048 + col]); const float y = u * (acc[cb][r] + bs[g * 128 + t]);
                Yb[(row0 + t) * 1024 + col] = (bf16)(pk2(y, y) & 0xffffu); }
        __syncthreads();
    }
}

__global__ void __launch_bounds__(512, 2) mk_fwd(Params P) {
    extern __shared__ __attribute__((aligned(16))) unsigned char lds_raw[];
    LAS unsigned char* lds = (LAS unsigned char*)lds_raw;
    cg::grid_group grid = cg::this_grid();
    volatile LAS unsigned* MISC = (volatile LAS unsigned*)(lds + LDS_BYTES - 64);
    if (threadIdx.x < 2) MISC[threadIdx.x] = 0u;
    __syncthreads();
    XcdBarrier xbar = xcd_barrier_post((unsigned*)P.ws, MISC);
    const int G = gridDim.x, bx = blockIdx.x;
    const int ngw = G * 8;
    unsigned char* ws = P.ws;
    bf16* Hb = (bf16*)(ws + WS_H);
    bf16* BIG = (bf16*)(ws + WS_BIG);
    bf16* Qb = BIG; bf16* Kb = BIG + (size_t)M * D; bf16* Vb = BIG + 2 * (size_t)M * D;
    float* Y = (float*)(ws + WS_Y);
    float* X = P.out;
    const float* norm_g = P.in[1];
    const int lo = P.ph_lo, hi_ph = P.ph_hi, coop = P.coop;
    int ph = 0;
#define PH_BEGIN if (ph >= lo && ph < hi_ph) { const int tid = otid(), lane = tid & 63, wid = __builtin_amdgcn_readfirstlane(tid >> 6), gw = bx * 8 + wid; (void)lane; (void)gw;
#define PH_END   if (coop && ph + 1 < hi_ph) { if (ph == 0) grid.sync(); else xcd_barrier(xbar); if (MK_DUP & 512) xcd_barrier(xbar); } } ++ph;

    PH_BEGIN
    for (int dup_ = 0; dup_ < DUPN(1); ++dup_) {
        LAS float* scr = (LAS float*)(lds + wid * 16640);
        constexpr int NIT = 4 * (2 * 1408 + 2 * 704) + 2 * (768 + 256) + (512 + 256) + (768 + 256);
        for (int it = gw; it < NIT; it += ngw) {
            int r = it;
            for (int mi = 0; mi < 24; ++mi) { const MatDesc md = get_mat(P, mi); const int cnt = (md.K >> 6) * (md.N >> 6);
                if (r < cnt) { transpose_item(md.W, md.K, md.N, md.WT, md.swiglu, scr, r, lane); break; } r -= cnt; }
        }
        { bf16* wsb = (bf16*)(ws + WS_WB + 6 * MiB); const float* w = P.in[12];
          for (int i = bx * 512 + tid; i < 8 * 128 * 128; i += G * 512) { const int t = (i >> 7) & 127, s = i & 127; const float v = (s <= t) ? w[i] : 0.f; wsb[i] = (bf16)(pk2(v, v) & 0xffffu); } }
        norm_phase(P.in[0], nullptr, 0.f, nullptr, norm_g, X, Hb, gw, ngw, lane);
    }
    PH_END

#pragma unroll 1
    for (int li = 0; li < NLAYER; ++li) {
        const float* g6 = norm_g + (size_t)li * 6 * D;
        const int kind = li % 3, jj = li / 3;
        unsigned char* wl = ws + WS_W + (size_t)li * 33 * MiB;
#pragma unroll 1
        for (int ff = 0; ff < 2; ++ff) {
            if (ff == 1) {
                PH_BEGIN
                for (int dup_ = 0; dup_ < DUPN(16); ++dup_)
                if (kind == 1) {
                    pg8::Gemm g{Hb, (const bf16*)(ws + WS_WB), M, 2 * D, D}; pg8::StaticOrder So; So.init(M, 2 * D, G, bx);
                    pg8::EpiBf16<1> E{BIG, 2 * D, nullptr, 0, 0, 1.f};
                    pg8::gemm_phase<pg8::EpiBf16<1>, pg8::StaticOrder, true, true>(lds, g, So, E);
                } else {
                    const bf16* wq = (kind == 0) ? (const bf16*)(ws + WS_WA + (size_t)jj * 8 * MiB) : (const bf16*)(ws + WS_WC);
                    pg8::Gemm g{Hb, wq, M, 3 * D, D}; pg8::StaticOrder So; So.init(M, 3 * D, G, bx);
                    pg8::EpiBf16<0> E{Qb, D, nullptr, D, (size_t)M * D, 0.125f * LOG2E};
                    pg8::gemm_phase<pg8::EpiBf16<0>, pg8::StaticOrder, true, true>(lds, g, So, E);
                }
                PH_END
                PH_BEGIN
                if (kind == 0) {
                    const float* relb = P.in[7] + (size_t)jj * 16 * 257;
                    for (int dup_ = DUPN(32) - 1; dup_ >= 0; --dup_)
                    for (int u = bx; u < 1024; u += G) att::unit_a(lds, Qb, Kb, Vb, dup_ ? Hb : Qb, relb, u >> 9, (u >> 5) & 15, u & 31);
                } else if (kind == 1) {
                    for (int dup_ = 0; dup_ < DUPN(128); ++dup_)
                    for (int u = bx; u < 256; u += G) spatial_unit(lds, BIG, BIG + 2 * (size_t)M * D, P.in[10], P.in[11], (const bf16*)(ws + WS_WB + 6 * MiB), P.in[13], u);
                } else {
                    const float* lam = P.in[16];
                    const float sa = wave_sum(lam[lane] * lam[64 + lane]), sb = wave_sum(lam[128 + lane] * lam[192 + lane]);
                    const float lam_full = __expf(sa) - __expf(sb) + P.lam_init;
                    for (int dup_ = DUPN(256) - 1; dup_ >= 0; --dup_)
                    for (int u = bx; u < 512; u += G) { const int v = u & 255, bh = v >> 4, s = v & 15; att::unit_c(lds, Qb, Kb, Vb, dup_ ? Hb : Qb, Y, lam_full, P.in[17], P.lam_init, bh >> 3, bh & 7, (u < 256) ? s : 31 - s); }
                }
                PH_END
                PH_BEGIN
                for (int dup_ = 0; dup_ < DUPN(64); ++dup_) {
                    const bf16* wo = (kind == 0) ? (const bf16*)(ws + WS_WA + (size_t)jj * 8 * MiB + 6 * MiB) : (kind == 1) ? (const bf16*)(ws + WS_WB + 4 * MiB) : (const bf16*)(ws + WS_WC + 6 * MiB);
                    const bf16* a = (kind == 1) ? BIG + 2 * (size_t)M * D : Qb;
                    pg8::Gemm g{a, wo, M, D, D}; pg8::StaticOrder So; So.init(M, D, G, bx);
                    pg8::EpiF32 E{Y, D};
                    pg8::gemm_phase<pg8::EpiF32, pg8::StaticOrder, false, true>(lds, g, So, E);
                }
                PH_END
                PH_BEGIN
                if (MK_DUP & 8) norm_phase(X, Y, 1.0f, g6 + 3 * D, g6 + 4 * D, nullptr, Hb, gw, ngw, lane);
                norm_phase(X, Y, 1.0f, g6 + 3 * D, g6 + 4 * D, X, Hb, gw, ngw, lane);
                PH_END
            }
            PH_BEGIN
            for (int dup_ = 0; dup_ < DUPN(2); ++dup_) {
                const bf16* win = (const bf16*)(wl + (ff ? 16 * MiB + MiB / 2 : 0));
                pg8::Gemm g{Hb, win, M, 2 * DFF, D}; pg8::StaticOrder So; So.init(M, 2 * DFF, G, bx);
                pg8::EpiSwiGLU E{BIG, DFF};
                pg8::gemm_phase<pg8::EpiSwiGLU, pg8::StaticOrder, true, true>(lds, g, So, E);
            }
            PH_END
            PH_BEGIN
            for (int dup_ = 0; dup_ < DUPN(4); ++dup_) {
                const bf16* wout = (const bf16*)(wl + (ff ? 27 * MiB + MiB / 2 : 11 * MiB));
                pg8::Gemm g{BIG, wout, M, D, DFF}; pg8::StaticOrder So; So.init(M, D, G, bx);
                pg8::EpiF32 E{Y, D};
                pg8::gemm_phase<pg8::EpiF32, pg8::StaticOrder, false, true>(lds, g, So, E);
            }
            PH_END
            PH_BEGIN
            {
                const float* gpost = g6 + (ff ? 5 : 1) * D;
                const float* gpre = ff ? (g6 + 6 * D) : (g6 + 2 * D);
                bf16* hout = (ff && li == NLAYER - 1) ? nullptr : Hb;
                if (MK_DUP & 8) norm_phase(X, Y, 0.5f, gpost, gpre, nullptr, Hb, gw, ngw, lane);
                norm_phase(X, Y, 0.5f, gpost, gpre, X, hout, gw, ngw, lane);
            }
            PH_END
        }
    }
#undef PH_BEGIN
#undef PH_END
}

constexpr int N_PHASES = 1 + NLAYER * 10;
#ifndef MK_MULTI
#define MK_MULTI 0
#endif

extern "C" void kernel_launch(void* const* d_in, const int* in_sizes, int n_in, void* d_out, int out_size, void* d_ws, size_t ws_size, hipStream_t stream) {
    static int grid = 0;
    if (grid == 0) {
        if (n_in != 19 || out_size != M * D || ws_size < WS_END) { fprintf(stderr, "kernel_launch: unexpected shapes n_in %d out %d ws %zu (need %zu)\n", n_in, out_size, ws_size, (size_t)WS_END); grid = -1; return; }
        int dev = 0, cus = 0, per_cu = 0;
        (void)hipGetDevice(&dev);
        (void)hipDeviceGetAttribute(&cus, hipDeviceAttributeMultiprocessorCount, dev);
        (void)hipFuncSetAttribute((const void*)mk_fwd, hipFuncAttributeMaxDynamicSharedMemorySize, LDS_BYTES);
        if (hipOccupancyMaxActiveBlocksPerMultiprocessor(&per_cu, (const void*)mk_fwd, 512, LDS_BYTES) != hipSuccess || per_cu < 1) per_cu = 1;
        (void)hipGetLastError();
        if (cus <= 0) cus = 256;
        grid = cus * 1;
    }
    if (grid < 0) return;
    (void)hipMemsetAsync(d_ws, 0, 65536, stream);
    Params p{};
    for (int i = 0; i < 19; ++i) p.in[i] = (const float*)d_in[i];
    p.out = (float*)d_out; p.ws = (unsigned char*)d_ws;
    p.lam_init = (float)(0.8 - 0.6 * exp(-0.3 * 2.0));
#if MK_MULTI
    for (int ph = 0; ph < N_PHASES; ++ph) {
        p.ph_lo = ph; p.ph_hi = ph + 1; p.coop = 0;
        hipLaunchKernelGGL(mk_fwd, dim3(grid), dim3(512), LDS_BYTES, stream, p);
    }
#else
    p.ph_lo = 0; p.ph_hi = N_PHASES; p.coop = 1;
    void* args[] = {&p};
    hipError_t e = hipLaunchCooperativeKernel((const void*)mk_fwd, dim3(grid), dim3(512), args, LDS_BYTES, stream);
    if (e != hipSuccess) fprintf(stderr, "cooperative launch failed: %s (grid %d)\n", hipGetErrorString(e), grid);
#endif
}
```
